# Optimizing an MI355X kernel written in HIP

```python
import jax, jax.numpy as jnp
from jax import lax
import numpy as np

D_MODEL = 1024
BATCH = 32
SEQ = 2048
DEPTH = 1
DEC_BATCH = 32
DEC_SEQ = 16
PAST_LEN = 1024

CHUNK = 64
N_MEM = 256
NORM_EPS = 1e-6
Q_BLOCK = 128
GM_CHUNK = 128
GM_GROUPS = 8
GM_GROUP_DIM = D_MODEL // GM_GROUPS
D_GM = GM_GROUPS * GM_GROUP_DIM
MLA_HEADS = 8
Q_LORA = 384
KV_LORA = 256
NOPE_DIM = 128
ROPE_DIM = 64
V_DIM = 128
D_MLA = MLA_HEADS * V_DIM
ROPE_THETA = 10000.0
MLA_SCALE = (NOPE_DIM + ROPE_DIM) ** -0.5
MEM_HEADS = 4
MEM_HEAD_DIM = 256
D_MEM = MEM_HEADS * MEM_HEAD_DIM
MEM_SCALE = MEM_HEAD_DIM ** -0.5
N_BRANCH = 3
D_FF = -(-(8 * D_MODEL) // (3 * 256)) * 256
IN_SIZES = (D_GM, D_GM, Q_LORA, KV_LORA, ROPE_DIM, D_MEM, D_MODEL, D_MODEL, D_MODEL)
IN_SPLITS = tuple(np.cumsum(IN_SIZES)[:-1].tolist())
D_IN = sum(IN_SIZES)

kernel_name = 'hybrid_gmlp_mla_memory_stream_step'


def rmsnorm(x, g):
    xf = x.astype(jnp.float32)
    y = xf * lax.rsqrt(jnp.mean(xf * xf, axis=-1, keepdims=True) + NORM_EPS)
    return (y * g.astype(jnp.float32)).astype(x.dtype)


def apply_rope(x, pos):
    inv = ROPE_THETA ** (-jnp.arange(0, ROPE_DIM, 2, dtype=jnp.float32) / ROPE_DIM)
    ang = pos.astype(jnp.float32)[:, None] * inv[None, :]
    ang = ang.reshape((ang.shape[0],) + (1,) * (x.ndim - 3) + (ang.shape[1],))
    cos, sin = jnp.cos(ang), jnp.sin(ang)
    x1, x2 = jnp.split(x.astype(jnp.float32), 2, axis=-1)
    return jnp.concatenate([x1 * cos - x2 * sin, x1 * sin + x2 * cos], axis=-1).astype(x.dtype)


def chunk_causal_mask(q_pos, k_pos):
    return (k_pos[None, :] // CHUNK) <= (q_pos[:, None] // CHUNK)


def gmlp_spatial(u, v, w_s, b_s):
    B, T, _ = v.shape
    n_chunks = -(-T // GM_CHUNK)
    pad = n_chunks * GM_CHUNK - T
    vp = jnp.pad(v, ((0, 0), (0, pad), (0, 0))).reshape(B, n_chunks, GM_CHUNK, GM_GROUPS, GM_GROUP_DIM)
    causal = jnp.tril(jnp.ones((GM_CHUNK, GM_CHUNK), dtype=bool))
    w = jnp.where(causal[None], w_s, jnp.zeros_like(w_s))
    mixed = jnp.einsum('gpq,bnqgc->bnpgc', w, vp) + b_s.T[None, None, :, :, None]
    mixed = mixed.reshape(B, n_chunks * GM_CHUNK, D_GM)[:, :T]
    return u * mixed


def mla_block(q_nope, q_rope, q_pos, k_nope, k_rope, v, k_pos):
    s = (jnp.einsum('bqhd,bkhd->bhqk', q_nope, k_nope)
         + jnp.einsum('bqhr,bkr->bhqk', q_rope, k_rope)).astype(jnp.float32) * MLA_SCALE
    s = jnp.where(chunk_causal_mask(q_pos, k_pos)[None, None], s, -jnp.inf)
    p = jax.nn.softmax(s, axis=-1).astype(v.dtype)
    return jnp.einsum('bhqk,bkhd->bqhd', p, v)


def mla_attention(q_nope, q_rope, q_pos, k_nope, k_rope, v, k_pos):
    B, T, H, _ = q_nope.shape
    if T % Q_BLOCK:
        return mla_block(q_nope, q_rope, q_pos, k_nope, k_rope, v, k_pos)
    nb = T // Q_BLOCK

    def to_blocks(a):
        return a.reshape((B, nb, Q_BLOCK) + a.shape[2:]).swapaxes(0, 1)

    out = lax.map(lambda blk: mla_block(blk[0], blk[1], blk[2], k_nope, k_rope, v, k_pos),
                  (to_blocks(q_nope), to_blocks(q_rope), q_pos.reshape(nb, Q_BLOCK)))
    return out.swapaxes(0, 1).reshape(B, T, H, V_DIM)


def memory_kv(mem, g, w_kv):
    B = mem.shape[0]
    kv = jnp.einsum('bmd,de->bme', rmsnorm(mem, g), w_kv)
    k, v = jnp.split(kv, 2, axis=-1)
    return (k.reshape(B, N_MEM, MEM_HEADS, MEM_HEAD_DIM), v.reshape(B, N_MEM, MEM_HEADS, MEM_HEAD_DIM))


def memory_attend(qm, mem_k, mem_v):
    B, T, _ = qm.shape
    q = qm.reshape(B, T, MEM_HEADS, MEM_HEAD_DIM)
    s = jnp.einsum('bthd,bmhd->bhtm', q, mem_k).astype(jnp.float32) * MEM_SCALE
    p = jax.nn.softmax(s, axis=-1).astype(mem_v.dtype)
    return jnp.einsum('bhtm,bmhd->bthd', p, mem_v).reshape(B, T, D_MEM)


def mixing_sublayer(x, pos, lp, ckv_past, kr_past, mem_k, mem_v):
    B, T, _ = x.shape
    xn = rmsnorm(x, lp['norm_mix_g'])
    z = jnp.einsum('btd,de->bte', xn, lp['w_in'])
    u, v, cq, ckv, kr, qm, ga, gb, gc = jnp.split(z, IN_SPLITS, axis=-1)
    u = jax.nn.gelu(u)
    v = rmsnorm(jax.nn.gelu(v), lp['gm_norm_g'])
    o_gm = gmlp_spatial(u, v, lp['gm_ws'], lp['gm_bs'])
    q = jnp.einsum('btc,chd->bthd', rmsnorm(cq, lp['q_norm_g']), lp['w_uq'])
    q_nope = q[..., :NOPE_DIM]
    q_rope = apply_rope(q[..., NOPE_DIM:], pos)
    ckv = rmsnorm(ckv, lp['kv_norm_g'])
    kr = apply_rope(kr, pos)
    if ckv_past is None:
        ckv_all, kr_all, k_pos = ckv, kr, pos
    else:
        ckv_all = jnp.concatenate([ckv_past, ckv], axis=1)
        kr_all = jnp.concatenate([kr_past, kr], axis=1)
        k_pos = jnp.arange(ckv_all.shape[1], dtype=jnp.int32)
    k_nope = jnp.einsum('bkc,chd->bkhd', ckv_all, lp['w_uk'])
    v_mla = jnp.einsum('bkc,chd->bkhd', ckv_all, lp['w_uv'])
    o_mla = mla_attention(q_nope, q_rope, pos, k_nope, kr_all, v_mla, k_pos).reshape(B, T, D_MLA)
    o_mem = memory_attend(qm, mem_k, mem_v)
    merged = (jax.nn.sigmoid(ga) * (o_gm @ lp['w_br_gm'])
              + jax.nn.sigmoid(gb) * (o_mla @ lp['w_br_mla'])
              + jax.nn.sigmoid(gc) * (o_mem @ lp['w_br_mem']))
    y = merged @ lp['w_out']
    return x + y, ckv, kr, v


def ffn_sublayer(h, lp):
    hn = rmsnorm(h, lp['norm_ffn_g'])
    a = jax.nn.silu(hn @ lp['ffn_w_gate']) * (hn @ lp['ffn_w_up'])
    return h + a @ lp['ffn_w_down']


def setup_inputs(seed: int = 0) -> dict:
    key = jax.random.key(seed)
    ks = iter(jax.random.split(key, 32))
    nrm = lambda shape, scale: jax.random.normal(next(ks), shape, jnp.float32) * scale
    gain = lambda shape: 1.0 + 0.01 * jax.random.normal(next(ks), shape, jnp.float32)
    L = DEPTH
    return {
        'x_prompt': nrm((BATCH, SEQ, D_MODEL), 1.0),
        'x_sample': nrm((DEC_BATCH, DEC_SEQ, D_MODEL), 1.0),
        'cache_mla_ckv': nrm((L, DEC_BATCH, PAST_LEN, KV_LORA), 1.0),
        'cache_mla_krope': nrm((L, DEC_BATCH, PAST_LEN, ROPE_DIM), 1.0),
        'cache_mem_k': nrm((L, DEC_BATCH, N_MEM, MEM_HEADS, MEM_HEAD_DIM), 1.0),
        'cache_mem_v': nrm((L, DEC_BATCH, N_MEM, MEM_HEADS, MEM_HEAD_DIM), 1.0),
        'mem_prompt': nrm((BATCH, N_MEM, D_MODEL), 1.0),
        'norm_mix_g': gain((L, D_MODEL)),
        'w_in': nrm((L, D_MODEL, D_IN), D_MODEL ** -0.5),
        'gm_norm_g': gain((L, D_GM)),
        'gm_ws': nrm((L, GM_GROUPS, GM_CHUNK, GM_CHUNK), GM_CHUNK ** -0.5),
        'gm_bs': nrm((L, GM_GROUPS, GM_CHUNK), 0.1),
        'mla_q_norm_g': gain((L, Q_LORA)),
        'mla_w_uq': nrm((L, Q_LORA, MLA_HEADS, NOPE_DIM + ROPE_DIM), Q_LORA ** -0.5),
        'mla_kv_norm_g': gain((L, KV_LORA)),
        'mla_w_uk': nrm((L, KV_LORA, MLA_HEADS, NOPE_DIM), KV_LORA ** -0.5),
        'mla_w_uv': nrm((L, KV_LORA, MLA_HEADS, V_DIM), KV_LORA ** -0.5),
        'mem_norm_g': gain((L, D_MODEL)),
        'mem_w_kv': nrm((L, D_MODEL, 2 * D_MEM), D_MODEL ** -0.5),
        'w_br_gm': nrm((L, D_GM, D_MODEL), D_GM ** -0.5),
        'w_br_mla': nrm((L, D_MLA, D_MODEL), D_MLA ** -0.5),
        'w_br_mem': nrm((L, D_MEM, D_MODEL), D_MEM ** -0.5),
        'w_out': nrm((L, D_MODEL, D_MODEL), D_MODEL ** -0.5),
        'norm_ffn_g': gain((L, D_MODEL)),
        'ffn_w_gate': nrm((L, D_MODEL, D_FF), D_MODEL ** -0.5),
        'ffn_w_up': nrm((L, D_MODEL, D_FF), D_MODEL ** -0.5),
        'ffn_w_down': nrm((L, D_FF, D_MODEL), D_FF ** -0.5),
        'final_norm_g': gain((D_MODEL,)),
    }


def reference(x_prompt, x_sample, cache_mla_ckv, cache_mla_krope, cache_mem_k, cache_mem_v, mem_prompt,
              norm_mix_g, w_in, gm_norm_g, gm_ws, gm_bs, mla_q_norm_g, mla_w_uq, mla_kv_norm_g, mla_w_uk,
              mla_w_uv, mem_norm_g, mem_w_kv, w_br_gm, w_br_mla, w_br_mem, w_out, norm_ffn_g,
              ffn_w_gate, ffn_w_up, ffn_w_down, final_norm_g):
    pos_p = jnp.arange(x_prompt.shape[1], dtype=jnp.int32)
    pos_s = PAST_LEN + jnp.arange(x_sample.shape[1], dtype=jnp.int32)
    hp, hs = x_prompt, x_sample
    ckv_p_l, kr_p_l, mk_p_l, mv_p_l, ckv_s_l, kr_s_l, gv_s_l = [], [], [], [], [], [], []
    for l in range(DEPTH):
        lp = {'norm_mix_g': norm_mix_g[l], 'w_in': w_in[l], 'gm_norm_g': gm_norm_g[l],
              'gm_ws': gm_ws[l], 'gm_bs': gm_bs[l], 'q_norm_g': mla_q_norm_g[l], 'w_uq': mla_w_uq[l],
              'kv_norm_g': mla_kv_norm_g[l], 'w_uk': mla_w_uk[l], 'w_uv': mla_w_uv[l],
              'w_br_gm': w_br_gm[l], 'w_br_mla': w_br_mla[l], 'w_br_mem': w_br_mem[l], 'w_out': w_out[l],
              'norm_ffn_g': norm_ffn_g[l], 'ffn_w_gate': ffn_w_gate[l], 'ffn_w_up': ffn_w_up[l],
              'ffn_w_down': ffn_w_down[l]}
        mk_p, mv_p = memory_kv(mem_prompt, mem_norm_g[l], mem_w_kv[l])
        hp, ckv_p, kr_p, _ = mixing_sublayer(hp, pos_p, lp, None, None, mk_p, mv_p)
        hp = ffn_sublayer(hp, lp)
        hs, ckv_s, kr_s, gv_s = mixing_sublayer(hs, pos_s, lp, cache_mla_ckv[l], cache_mla_krope[l],
                                                cache_mem_k[l], cache_mem_v[l])
        hs = ffn_sublayer(hs, lp)
        ckv_p_l.append(ckv_p); kr_p_l.append(kr_p); mk_p_l.append(mk_p); mv_p_l.append(mv_p)
        ckv_s_l.append(ckv_s); kr_s_l.append(kr_s); gv_s_l.append(gv_s)
    y_prompt = rmsnorm(hp, final_norm_g)
    y_sample = rmsnorm(hs, final_norm_g)
    new_mla_ckv_prompt = jnp.stack(ckv_p_l)
    new_mla_krope_prompt = jnp.stack(kr_p_l)
    new_mem_k_prompt = jnp.stack(mk_p_l)
    new_mem_v_prompt = jnp.stack(mv_p_l)
    new_mla_ckv_sample = jnp.stack(ckv_s_l)
    new_mla_krope_sample = jnp.stack(kr_s_l)
    new_gm_v_sample = jnp.stack(gv_s_l)
    return (y_prompt, y_sample, new_mla_ckv_prompt, new_mla_krope_prompt, new_mem_k_prompt,
            new_mem_v_prompt, new_mla_ckv_sample, new_mla_krope_sample, new_gm_v_sample)
```

```cpp
#include <hip/hip_runtime.h>
#include <hip/hip_cooperative_groups.h>
#include <cstdio>
namespace cg = cooperative_groups;

#define LAS __attribute__((address_space(3)))
#define DI __device__ __forceinline__
typedef unsigned short bf16_t;
typedef short bf16x8 __attribute__((ext_vector_type(8)));
typedef float f32x4 __attribute__((ext_vector_type(4)));
typedef float f32x16 __attribute__((ext_vector_type(16)));
typedef unsigned u32x4 __attribute__((ext_vector_type(4)));
typedef unsigned u32x2 __attribute__((ext_vector_type(2)));
typedef __bf16 bfv2 __attribute__((ext_vector_type(2)));
typedef float fv2 __attribute__((ext_vector_type(2)));

constexpr int D = 1024, SEQ = 2048, MP = 65536, MS = 512, TS = 16, PAST = 1024, KALL = 1040, KPAD = 1088;
constexpr int NGRP = 4, MG = MP / NGRP, BG = 32 / NGRP;
constexpr int NZ = 6912;
constexpr int ZU = 0, ZV = 1024, ZCQ = 2048, ZKR = 2432, ZCKV = 2560, ZQM = 2816, ZGA = 3840;
constexpr int DFF = 2816, NGU = 5632;
constexpr float EPS = 1e-6f;
constexpr float LOG2E = 1.4426950408889634f;
constexpr float QSCALE = 0.07216878364870322f * LOG2E;
constexpr float MSCALE = 0.0625f * LOG2E;
constexpr int NSTAT = MP + MS;

constexpr size_t O_YP = 0, O_YS = 67108864, O_CKVP = 67633152, O_KRP = 84410368, O_MKP = 88604672, O_MVP = 96993280,
                 O_CKVS = 105381888, O_KRS = 105512960, O_GVS = 105545728;

constexpr size_t al256(size_t x) { return (x + 255) & ~(size_t)255; }
constexpr size_t WS_WIN = 0;
constexpr size_t WS_WUQ = WS_WIN + al256((size_t)NZ * 1024 * 2);
constexpr size_t WS_WUKF = WS_WUQ + al256((size_t)1536 * 384 * 2);
constexpr size_t WS_WUKP = WS_WUKF + 524288;
constexpr size_t WS_WUVF = WS_WUKP + 524288;
constexpr size_t WS_WUVP = WS_WUVF + 524288;
constexpr size_t WS_WKV = WS_WUVP + 524288;
constexpr size_t WS_WBG = WS_WKV + (size_t)2048 * 1024 * 2;
constexpr size_t WS_WBM = WS_WBG + 2097152;
constexpr size_t WS_WBE = WS_WBM + 2097152;
constexpr size_t WS_WOUT = WS_WBE + 2097152;
constexpr size_t WS_WGU = WS_WOUT + 2097152;
constexpr size_t WS_WDN = WS_WGU + (size_t)NGU * 1024 * 2;
constexpr size_t WS_WS = WS_WDN + (size_t)1024 * DFF * 2;
constexpr size_t WS_STAT = WS_WS + 262144;
constexpr size_t WS_BAR = WS_STAT + al256((size_t)5 * NSTAT * 4);
constexpr size_t WS_MEMN = WS_BAR + 131072;
constexpr size_t WS_MK = WS_MEMN + (size_t)8192 * 1024 * 2;
constexpr size_t WS_MVT = WS_MK + (size_t)8192 * 1024 * 2;
constexpr size_t WS_XN = WS_MVT + (size_t)8192 * 1024 * 2;
constexpr size_t WS_Z = WS_XN + (size_t)MG * 1024 * 2;
constexpr size_t WS_Q = WS_Z + (size_t)MG * NZ * 2;
constexpr size_t WS_KN = WS_Q + (size_t)MG * 1536 * 2;
constexpr size_t WS_VT = WS_KN + (size_t)MG * 1024 * 2;
constexpr size_t WS_KR = WS_VT + (size_t)MG * 1024 * 2;
constexpr size_t WS_OG = WS_KR + (size_t)MG * 64 * 2;
constexpr size_t WS_OM = WS_OG + (size_t)MG * 1024 * 2;
constexpr size_t WS_OE = WS_OM + (size_t)MG * 1024 * 2;
constexpr size_t WS_MRG = WS_OE + (size_t)MG * 1024 * 2;
constexpr size_t WS_HB = WS_MRG + (size_t)MG * 1024 * 2;
constexpr size_t WS_ACT = WS_HB + (size_t)MG * 1024 * 2;
constexpr size_t WS_XNS = WS_ACT + (size_t)MG * DFF * 2;
constexpr size_t WS_ZS = WS_XNS + (size_t)MS * 1024 * 2;
constexpr size_t WS_QS = WS_ZS + (size_t)MS * NZ * 2;
constexpr size_t WS_CKVALL = WS_QS + (size_t)MS * 1536 * 2;
constexpr size_t WS_KRALL = WS_CKVALL + (size_t)32 * KPAD * 256 * 2;
constexpr size_t WS_KNS = WS_KRALL + (size_t)32 * KPAD * 64 * 2;
constexpr size_t WS_VTS = WS_KNS + (size_t)32 * KPAD * 1024 * 2;
constexpr size_t WS_MKS = WS_VTS + (size_t)32 * KPAD * 1024 * 2;
constexpr size_t WS_MVTS = WS_MKS + (size_t)8192 * 1024 * 2;
constexpr size_t WS_OGS = WS_MVTS + (size_t)8192 * 1024 * 2;
constexpr size_t WS_OMS = WS_OGS + (size_t)MS * 1024 * 2;
constexpr size_t WS_OES = WS_OMS + (size_t)MS * 1024 * 2;
constexpr size_t WS_MRGS = WS_OES + (size_t)MS * 1024 * 2;
constexpr size_t WS_HBS = WS_MRGS + (size_t)MS * 1024 * 2;
constexpr size_t WS_ACTS = WS_HBS + (size_t)MS * 1024 * 2;
constexpr size_t WS_END = WS_ACTS + (size_t)MS * DFF * 2;
static_assert((size_t)MG * DFF * 2 <= (size_t)MG * NZ * 2, "ACT aliases Z");
static_assert(WS_END <= (size_t)1000 * 1024 * 1024, "workspace");

constexpr int LDS_BYTES = 135168;

DI unsigned pk2(float lo, float hi) { fv2 v = {lo, hi}; return __builtin_bit_cast(unsigned, __builtin_convertvector(v, bfv2)); }
DI float bflo(unsigned w) { return __uint_as_float(w << 16); }
DI float bfhi(unsigned w) { return __uint_as_float(w & 0xffff0000u); }
DI float ex2(float x) { return __builtin_amdgcn_exp2f(x); }
DI float rcpf(float x) { return __builtin_amdgcn_rcpf(x); }
DI float sigm(float x) { return rcpf(1.0f + ex2(-x * LOG2E)); }
DI float gelu_t(float x) { const float t = x * (1.0f + 0.044715f * x * x) * 2.3022081985f; return x * rcpf(1.0f + ex2(-t)); }
DI float max16(const f32x16& x) { float r;
    asm volatile("s_nop 15\n\tv_max3_f32 %0, %1, %2, %3\n\tv_max3_f32 %0, %0, %4, %5\n\tv_max3_f32 %0, %0, %6, %7\n\tv_max3_f32 %0, %0, %8, %9\n\tv_max3_f32 %0, %0, %10, %11\n\tv_max3_f32 %0, %0, %12, %13\n\tv_max3_f32 %0, %0, %14, %15\n\tv_max_f32 %0, %0, %16"
                 : "=&v"(r) : "v"(x[0]), "v"(x[1]), "v"(x[2]), "v"(x[3]), "v"(x[4]), "v"(x[5]), "v"(x[6]), "v"(x[7]), "v"(x[8]), "v"(x[9]), "v"(x[10]), "v"(x[11]), "v"(x[12]), "v"(x[13]), "v"(x[14]), "v"(x[15]));
    return r; }
DI int lane_id() { int l; asm volatile("v_mbcnt_lo_u32_b32 %0, -1, 0\n\tv_mbcnt_hi_u32_b32 %0, -1, %0" : "=v"(l)); return l; }
DI float wave_sum(float v) {
#pragma unroll
    for (int o = 1; o < 64; o <<= 1) v += __shfl_xor(v, o);
    return v;
}
DI void rope_pair(float x1, float x2, int i, float pos, float& y1, float& y2) {
    const float inv = ex2(-(float)i * 0.41524101186092029f);
    const float rev = pos * inv * 0.15915494309189535f;
    const float fr = rev - floorf(rev);
    const float s = __builtin_amdgcn_sinf(fr), c = __builtin_amdgcn_cosf(fr);
    y1 = x1 * c - x2 * s; y2 = x1 * s + x2 * c;
}

namespace pg8 {
constexpr int BM = 256, BK = 64, HALF = 128, HTB = HALF * BK * 2, STAGE_BYTES = 8 * HTB, NXCD = 8, WGM = 8;
DI int lds_byte(int r, int c) { const int st = (r >> 4) * 2 + (c >> 5), rr = r & 15, cc = c & 31, ob = rr * 64 + cc * 2; return st * 1024 + (ob ^ (((ob >> 9) & 1) << 5)); }
DI void stage_rc(int b, int& R, int& C) { const int st = b / 1024, sb = b % 1024, swz = sb ^ (((sb >> 9) & 1) << 5); R = (st >> 1) * 16 + swz / 64; C = (st & 1) * 32 + (swz % 64) / 2; }
DI int perm32(int rho) { const int n = rho >> 4, i = rho & 15; return 8 * (i >> 2) + 4 * n + (i & 3); }
struct Unit { int pm, pn; };
struct Gemm { const bf16_t* A; const bf16_t* Bt; int M, N, K, lda, ldb; };
struct StaticOrder {
    int nM, nN, nwg, G, c;
    DI void init(int M, int N, int G_, int c_) { nM = M / BM; nN = N / BM; nwg = nM * nN; G = G_; c = c_; }
    DI bool next(int i, Unit& u) const {
        const long L = (long)i * G + c; if (L >= nwg) return false;
        int wgid = (int)L; { const int q = nwg / NXCD, r = nwg % NXCD, xcd = wgid % NXCD, off = wgid / NXCD; wgid = (xcd < r ? xcd * (q + 1) : r * (q + 1) + (xcd - r) * q) + off; }
        const int nig = WGM * nN, gid = wgid / nig, fm = gid * WGM, gsz = (nM - fm) < WGM ? (nM - fm) : WGM;
        u.pm = fm + ((wgid % nig) % gsz); u.pn = (wgid % nig) / gsz; return true;
    }
};

template <class Epi>
DI void gemm_phase(LAS unsigned char* lds, const Gemm g, const StaticOrder& S, const Epi& E, const int tid) {
    const int wid = __builtin_amdgcn_readfirstlane(tid >> 6), lane = tid & 63, wr = wid >> 2, wc = wid & 3, fr = lane & 15, fq = lane >> 4;
    const int K = g.K, nt = K / BK;
    unsigned voffA, voffB; const unsigned vstoffA = (unsigned)g.lda * 128u, vstoffB = (unsigned)g.ldb * 128u;
    { int R, C; stage_rc(tid * 16, R, C); const int Rb = Epi::PERM ? ((R & ~31) + perm32(R & 31)) : R;
        voffA = (unsigned)(R * g.lda + C) * 2u; voffB = (unsigned)(Rb * g.ldb + C) * 2u; }
    const size_t kstep = (size_t)(BK * 2);
    const size_t hsA = (size_t)HALF * g.lda * 2, hsB = (size_t)HALF * g.ldb * 2;
    const size_t tsA = 2 * hsA, tsB = 2 * hsB;
    const unsigned ldsw = (unsigned)wid * 1024u;
    const int aoff = lds_byte(wr * 64 + fr, fq * 8), boff = lds_byte(wc * 32 + fr, fq * 8);
#define PG8_SA(b, h) (((b) * 2 + (h)) * HTB)
#define PG8_SB(b, h) ((4 + (b) * 2 + (h)) * HTB)
#define PG8_STAGE(bufoff, gbase, voff) do { _Pragma("unroll") for (int _i = 0; _i < 2; ++_i) \
        __builtin_amdgcn_global_load_lds((const unsigned*)((const char*)(gbase) + (size_t)_i * vst##voff + v##voff), (LAS unsigned*)(lds + (bufoff) + ldsw + _i * 8192), 16, 0, 0); } while (0)
#define PG8_LDA(dst, b, h) do { _Pragma("unroll") for (int m = 0; m < 4; ++m) _Pragma("unroll") for (int k = 0; k < 2; ++k) dst[m][k] = *(const LAS bf16x8*)(lds + PG8_SA(b, h) + aoff + m * 2048 + k * 1024); } while (0)
#define PG8_LDB(dst, b, h) do { _Pragma("unroll") for (int n = 0; n < 2; ++n) _Pragma("unroll") for (int k = 0; k < 2; ++k) dst[n][k] = *(const LAS bf16x8*)(lds + PG8_SB(b, h) + boff + n * 2048 + k * 1024); } while (0)
#define PG8_MMA(ai, bj, At, Bt) do { __builtin_amdgcn_s_setprio(1); _Pragma("unroll") for (int m = 0; m < 4; ++m) _Pragma("unroll") for (int n = 0; n < 2; ++n) _Pragma("unroll") for (int k = 0; k < 2; ++k) \
        acc[ai][bj][m][n] = __builtin_amdgcn_mfma_f32_16x16x32_bf16(Bt[n][k], At[m][k], acc[ai][bj][m][n], 0, 0, 0); __builtin_amdgcn_s_setprio(0); } while (0)
#define PG8_WAIT_V(n) asm volatile("s_waitcnt vmcnt(" #n ")" ::: "memory")
#define PG8_WAIT_L(n) asm volatile("s_waitcnt lgkmcnt(" #n ")" ::: "memory")
#define PG8_BAR __builtin_amdgcn_s_barrier()
#define PG8_SCHED __builtin_amdgcn_sched_barrier(0)
    Unit cur, nxt; int ui = 0;
    if (!S.next(0, cur)) return;
    f32x4 acc[2][2][4][2];
#pragma unroll
    for (int a = 0; a < 2; ++a)
#pragma unroll
        for (int b = 0; b < 2; ++b)
#pragma unroll
            for (int m = 0; m < 4; ++m)
#pragma unroll
                for (int n = 0; n < 2; ++n) acc[a][b][m][n] = (f32x4){0.f, 0.f, 0.f, 0.f};
    bf16x8 At[4][2], B0[2][2], B1[2][2];
    const char* cA = (const char*)g.A + (size_t)cur.pm * tsA; const char* cB = (const char*)g.Bt + (size_t)cur.pn * tsB;
    PG8_STAGE(PG8_SB(0, 0), cB, offB); PG8_STAGE(PG8_SA(0, 0), cA, offA); PG8_STAGE(PG8_SB(0, 1), cB + hsB, offB); PG8_STAGE(PG8_SA(0, 1), cA + hsA, offA);
    if (wr == 1) PG8_BAR;
    PG8_WAIT_V(4); PG8_BAR;
    PG8_STAGE(PG8_SB(1, 0), cB + kstep, offB); PG8_STAGE(PG8_SA(1, 0), cA + kstep, offA); PG8_STAGE(PG8_SB(1, 1), cB + hsB + kstep, offB);
    PG8_WAIT_V(6); PG8_BAR;
    for (;;) {
        const bool has_next = S.next(ui + 1, nxt);
        const char* nA = has_next ? (const char*)g.A + (size_t)nxt.pm * tsA : cA; const char* nB = has_next ? (const char*)g.Bt + (size_t)nxt.pn * tsB : cB;
        for (int t = 0; t < nt; t += 2) {
            const bool last = (t == nt - 2);
            const char* a1 = cA + (size_t)(t + 1) * kstep;
            const char* a2 = last ? nA : cA + (size_t)(t + 2) * kstep; const char* b2 = last ? nB : cB + (size_t)(t + 2) * kstep;
            const char* a3 = a2 + kstep; const char* b3 = b2 + kstep;
            PG8_LDB(B0, 0, 0); PG8_SCHED; PG8_LDA(At, 0, 0); PG8_STAGE(PG8_SA(1, 1), a1 + hsA, offA);
            PG8_WAIT_L(8); PG8_BAR; PG8_WAIT_L(0); PG8_MMA(0, 0, At, B0); PG8_BAR; PG8_SCHED;
            PG8_LDB(B1, 0, 1); PG8_STAGE(PG8_SB(0, 0), b2, offB);
            PG8_BAR; PG8_WAIT_L(0); PG8_MMA(0, 1, At, B1); PG8_BAR;
            PG8_LDA(At, 0, 1); PG8_STAGE(PG8_SA(0, 0), a2, offA);
            PG8_BAR; PG8_WAIT_L(0); PG8_MMA(1, 0, At, B0); PG8_BAR; PG8_SCHED;
            PG8_STAGE(PG8_SB(0, 1), b2 + hsB, offB);
            PG8_WAIT_V(6); PG8_BAR; PG8_MMA(1, 1, At, B1); PG8_BAR;
            PG8_LDB(B0, 1, 0); PG8_SCHED; PG8_LDA(At, 1, 0); PG8_STAGE(PG8_SA(0, 1), a2 + hsA, offA);
            PG8_WAIT_L(8); PG8_BAR; PG8_WAIT_L(0); PG8_MMA(0, 0, At, B0); PG8_BAR; PG8_SCHED;
            PG8_LDB(B1, 1, 1); PG8_STAGE(PG8_SB(1, 0), b3, offB);
            PG8_BAR; PG8_WAIT_L(0); PG8_MMA(0, 1, At, B1); PG8_BAR;
            PG8_LDA(At, 1, 1); PG8_STAGE(PG8_SA(1, 0), a3, offA);
            PG8_BAR; PG8_WAIT_L(0); PG8_MMA(1, 0, At, B0); PG8_BAR; PG8_SCHED;
            PG8_STAGE(PG8_SB(1, 1), b3 + hsB, offB);
            PG8_WAIT_V(6); PG8_BAR; PG8_MMA(1, 1, At, B1); PG8_BAR;
        }
        if constexpr (!Epi::AFTER_DRAIN) { const int t2 = lane_id(); E(acc, cur, wr, wc, t2 & 15, t2 >> 4); }
        if (!has_next) break;
#pragma unroll
        for (int a = 0; a < 2; ++a)
#pragma unroll
            for (int b = 0; b < 2; ++b)
#pragma unroll
                for (int m = 0; m < 4; ++m)
#pragma unroll
                    for (int n = 0; n < 2; ++n) acc[a][b][m][n] = (f32x4){0.f, 0.f, 0.f, 0.f};
        cur = nxt; cA = nA; cB = nB; ++ui;
    }
    PG8_WAIT_V(0);
    if (wr == 0) PG8_BAR;
    PG8_BAR;
    if constexpr (Epi::AFTER_DRAIN) { const int t2 = lane_id(); E.fused(acc, cur, wr, wc, t2 & 15, t2 >> 4, wid, t2); }
#undef PG8_SA
#undef PG8_SB
#undef PG8_STAGE
#undef PG8_LDA
#undef PG8_LDB
#undef PG8_MMA
#undef PG8_WAIT_V
#undef PG8_WAIT_L
#undef PG8_BAR
#undef PG8_SCHED
}
}
using pg8::Unit;
typedef f32x4 AccT[2][2][4][2];

template <class Epi>
DI void run_gemm_(LAS unsigned char* lds, const bf16_t* A, int lda, const bf16_t* Bt, int ldb, int M, int N, int K, bool rev, const Epi& E, int wid0) {
    pg8::Gemm g{A, Bt, M, N, K, lda, ldb}; pg8::StaticOrder S; const int G = (int)gridDim.x;
    S.init(M, N, G, rev ? G - 1 - (int)blockIdx.x : (int)blockIdx.x);
    const int tidv = wid0 * 64 + lane_id();
    pg8::gemm_phase<Epi>(lds, g, S, E, tidv);
}

DI void st8(bf16_t* p, f32x4 a, f32x4 b) { u32x4 w; w.x = pk2(a[0], a[1]); w.y = pk2(a[2], a[3]); w.z = pk2(b[0], b[1]); w.w = pk2(b[2], b[3]); *(u32x4*)p = w; }

struct EpiInproj {
    static constexpr bool PERM = true, AFTER_DRAIN = false;
    bf16_t* Z; bf16_t* KR; float* krout; float* sv; float* sq; float* skv; int T, Tpad, off, pos0;
    DI void operator()(const AccT& acc, const Unit& u, int wr, int wc, int fr, int fq) const {
        const int pn = u.pn;
        float* stp = (pn >= 4 && pn < 8) ? sv : ((pn == 8 || pn == 9) ? sq : (pn == 10 ? skv : nullptr));
#pragma unroll
        for (int ai = 0; ai < 2; ++ai)
#pragma unroll
            for (int m = 0; m < 4; ++m) {
                const int row = u.pm * 256 + ai * 128 + wr * 64 + m * 16 + fr;
                float ss = 0.f;
#pragma unroll
                for (int bj = 0; bj < 2; ++bj) {
                    f32x4 a = acc[ai][bj][m][0], b = acc[ai][bj][m][1];
                    const int col0 = pn * 256 + bj * 128 + wc * 32 + fq * 8;
                    if (pn == 9 && bj == 1) {
                        if (wc >= 2) continue;
                        const int kc = wc * 32 + fq * 8, i0 = kc >> 1; const float pos = (float)(pos0 + (row % T));
                        f32x4 y1, y2; float p, q;
                        rope_pair(a[0], a[1], i0 + 0, pos, p, q); y1[0] = p; y2[0] = q;
                        rope_pair(a[2], a[3], i0 + 1, pos, p, q); y1[1] = p; y2[1] = q;
                        rope_pair(b[0], b[1], i0 + 2, pos, p, q); y1[2] = p; y2[2] = q;
                        rope_pair(b[2], b[3], i0 + 3, pos, p, q); y1[3] = p; y2[3] = q;
                        *(f32x4*)(krout + (size_t)row * 64 + i0) = y1; *(f32x4*)(krout + (size_t)row * 64 + 32 + i0) = y2;
                        const size_t dr = (size_t)(row / T) * Tpad + off + (row % T);
                        u32x4 w; w.x = pk2(y1[0], y2[0]); w.y = pk2(y1[1], y2[1]); w.z = pk2(y1[2], y2[2]); w.w = pk2(y1[3], y2[3]);
                        *(u32x4*)(KR + dr * 64 + kc) = w;
                        continue;
                    }
                    if (pn < 8) {
#pragma unroll
                        for (int j = 0; j < 4; ++j) { a[j] = gelu_t(a[j]); b[j] = gelu_t(b[j]); }
                    } else if (pn >= 15) {
#pragma unroll
                        for (int j = 0; j < 4; ++j) { a[j] = sigm(a[j]); b[j] = sigm(b[j]); }
                    } else if (pn >= 11) { a = a * MSCALE; b = b * MSCALE; }
                    ss += (a[0] * a[0] + a[1] * a[1]) + (a[2] * a[2] + a[3] * a[3]) + (b[0] * b[0] + b[1] * b[1]) + (b[2] * b[2] + b[3] * b[3]);
                    st8(Z + (size_t)row * NZ + col0, a, b);
                }
                if (stp) { ss += __shfl_xor(ss, 16); ss += __shfl_xor(ss, 32); if (fq == 0) atomicAdd(stp + row, ss); }
            }
    }
};

struct EpiQ {
    static constexpr bool PERM = true, AFTER_DRAIN = false;
    bf16_t* Q; const float* sq; int T, pos0;
    DI void operator()(const AccT& acc, const Unit& u, int wr, int wc, int fr, int fq) const {
        float sv_[2][4];
#pragma unroll
        for (int ai = 0; ai < 2; ++ai)
#pragma unroll
            for (int m = 0; m < 4; ++m) sv_[ai][m] = sq[u.pm * 256 + ai * 128 + wr * 64 + m * 16 + fr];
#pragma unroll
        for (int ai = 0; ai < 2; ++ai)
#pragma unroll
            for (int m = 0; m < 4; ++m) {
                const int row = u.pm * 256 + ai * 128 + wr * 64 + m * 16 + fr;
                const float rs = rsqrtf(sv_[ai][m] * (1.0f / 384.0f) + EPS) * QSCALE; const float pos = (float)(pos0 + (row % T));
#pragma unroll
                for (int bj = 0; bj < 2; ++bj) {
                    f32x4 a = acc[ai][bj][m][0] * rs, b = acc[ai][bj][m][1] * rs;
                    const int col0 = u.pn * 256 + bj * 128 + wc * 32 + fq * 8, d = col0 % 192;
                    if (d >= 128) { const int i0 = (d - 128) >> 1; float p, q;
                        rope_pair(a[0], a[1], i0 + 0, pos, p, q); a[0] = p; a[1] = q;
                        rope_pair(a[2], a[3], i0 + 1, pos, p, q); a[2] = p; a[3] = q;
                        rope_pair(b[0], b[1], i0 + 2, pos, p, q); b[0] = p; b[1] = q;
                        rope_pair(b[2], b[3], i0 + 3, pos, p, q); b[2] = p; b[3] = q; }
                    st8(Q + (size_t)row * 1536 + col0, a, b);
                }
            }
    }
};

struct EpiRowScale {
    static constexpr bool PERM = true, AFTER_DRAIN = false;
    bf16_t* O; int ldc; const float* st; float invn;
    DI void operator()(const AccT& acc, const Unit& u, int wr, int wc, int fr, int fq) const {
        float sv_[2][4];
#pragma unroll
        for (int ai = 0; ai < 2; ++ai)
#pragma unroll
            for (int m = 0; m < 4; ++m) sv_[ai][m] = st ? st[u.pm * 256 + ai * 128 + wr * 64 + m * 16 + fr] : 0.f;
#pragma unroll
        for (int ai = 0; ai < 2; ++ai)
#pragma unroll
            for (int m = 0; m < 4; ++m) {
                const int row = u.pm * 256 + ai * 128 + wr * 64 + m * 16 + fr;
                const float rs = st ? rsqrtf(sv_[ai][m] * invn + EPS) : 1.0f;
#pragma unroll
                for (int bj = 0; bj < 2; ++bj) st8(O + (size_t)row * ldc + u.pn * 256 + bj * 128 + wc * 32 + fq * 8, acc[ai][bj][m][0] * rs, acc[ai][bj][m][1] * rs);
            }
    }
};

struct EpiVT {
    static constexpr bool PERM = true, AFTER_DRAIN = false;
    bf16_t* O; int Tk; const float* st;
    DI void operator()(const AccT& acc, const Unit& u, int wr, int wc, int fr, int fq) const {
        f32x4 sa[2][2];
#pragma unroll
        for (int bj = 0; bj < 2; ++bj) { const int c0 = u.pn * 256 + bj * 128 + wc * 32 + fq * 8;
            sa[bj][0] = st ? *(const f32x4*)(st + c0) : (f32x4){0.f, 0.f, 0.f, 0.f}; sa[bj][1] = st ? *(const f32x4*)(st + c0 + 4) : (f32x4){0.f, 0.f, 0.f, 0.f}; }
#pragma unroll
        for (int bj = 0; bj < 2; ++bj) {
            const int c0 = u.pn * 256 + bj * 128 + wc * 32 + fq * 8, b = c0 / Tk, key = c0 % Tk;
            f32x4 r0 = {1.f, 1.f, 1.f, 1.f}, r1 = r0;
            if (st) { const f32x4 s0 = sa[bj][0], s1 = sa[bj][1];
#pragma unroll
                for (int j = 0; j < 4; ++j) { r0[j] = rsqrtf(s0[j] * (1.0f / 256.0f) + EPS); r1[j] = rsqrtf(s1[j] * (1.0f / 256.0f) + EPS); } }
#pragma unroll
            for (int ai = 0; ai < 2; ++ai)
#pragma unroll
                for (int m = 0; m < 4; ++m) {
                    const int f = u.pm * 256 + ai * 128 + wr * 64 + m * 16 + fr;
                    st8(O + ((size_t)b * 1024 + f) * Tk + key, acc[ai][bj][m][0] * r0, acc[ai][bj][m][1] * r1);
                }
        }
    }
};

struct EpiMemKV {
    static constexpr bool PERM = false, AFTER_DRAIN = false;
    float* outK; float* outV; bf16_t* MK;
    DI void operator()(const AccT& acc, const Unit& u, int wr, int wc, int fr, int fq) const {
#pragma unroll
        for (int ai = 0; ai < 2; ++ai)
#pragma unroll
            for (int m = 0; m < 4; ++m) {
                const int row = u.pm * 256 + ai * 128 + wr * 64 + m * 16 + fr;
#pragma unroll
                for (int bj = 0; bj < 2; ++bj)
#pragma unroll
                    for (int n = 0; n < 2; ++n) {
                        const int col = u.pn * 256 + bj * 128 + wc * 32 + n * 16 + fq * 4; const f32x4 v = acc[ai][bj][m][n];
                        if (u.pn < 4) { *(f32x4*)(outK + (size_t)row * 1024 + col) = v; u32x2 w; w.x = pk2(v[0], v[1]); w.y = pk2(v[2], v[3]); *(u32x2*)(MK + (size_t)row * 1024 + col) = w; }
                        else *(f32x4*)(outV + (size_t)row * 1024 + col - 1024) = v;
                    }
            }
    }
};

struct EpiMerge {
    static constexpr bool PERM = true, AFTER_DRAIN = false;
    const bf16_t* gate; bf16_t* MRG; int first;
    DI void operator()(const AccT& acc, const Unit& u, int wr, int wc, int fr, int fq) const {
#pragma unroll
        for (int ai = 0; ai < 2; ++ai) {
            u32x4 gw[4][2], pw[4][2];
#pragma unroll
            for (int m = 0; m < 4; ++m)
#pragma unroll
                for (int bj = 0; bj < 2; ++bj) {
                    const int row = u.pm * 256 + ai * 128 + wr * 64 + m * 16 + fr, col0 = u.pn * 256 + bj * 128 + wc * 32 + fq * 8;
                    gw[m][bj] = *(const u32x4*)(gate + (size_t)row * NZ + col0);
                    pw[m][bj] = first ? (u32x4){0u, 0u, 0u, 0u} : *(const u32x4*)(MRG + (size_t)row * 1024 + col0);
                }
#pragma unroll
            for (int m = 0; m < 4; ++m)
#pragma unroll
                for (int bj = 0; bj < 2; ++bj) {
                    const int row = u.pm * 256 + ai * 128 + wr * 64 + m * 16 + fr, col0 = u.pn * 256 + bj * 128 + wc * 32 + fq * 8;
                    const u32x4 g4 = gw[m][bj], p4 = pw[m][bj];
                    f32x4 a = acc[ai][bj][m][0], b = acc[ai][bj][m][1];
                    a[0] = a[0] * bflo(g4.x) + bflo(p4.x); a[1] = a[1] * bfhi(g4.x) + bfhi(p4.x); a[2] = a[2] * bflo(g4.y) + bflo(p4.y); a[3] = a[3] * bfhi(g4.y) + bfhi(p4.y);
                    b[0] = b[0] * bflo(g4.z) + bflo(p4.z); b[1] = b[1] * bfhi(g4.z) + bfhi(p4.z); b[2] = b[2] * bflo(g4.w) + bflo(p4.w); b[3] = b[3] * bfhi(g4.w) + bfhi(p4.w);
                    st8(MRG + (size_t)row * 1024 + col0, a, b);
                }
        }
    }
};

struct EpiOut {
    static constexpr bool PERM = false, AFTER_DRAIN = false;
    const float* X; bf16_t* HB; float* sh;
    DI void operator()(const AccT& acc, const Unit& u, int wr, int wc, int fr, int fq) const {
#pragma unroll
        for (int ai = 0; ai < 2; ++ai)
#pragma unroll
            for (int mp = 0; mp < 2; ++mp) {
                f32x4 xv[2][2][2];
#pragma unroll
                for (int mm = 0; mm < 2; ++mm)
#pragma unroll
                    for (int bj = 0; bj < 2; ++bj)
#pragma unroll
                        for (int n = 0; n < 2; ++n) {
                            const int row = u.pm * 256 + ai * 128 + wr * 64 + (2 * mp + mm) * 16 + fr;
                            xv[mm][bj][n] = *(const f32x4*)(X + (size_t)row * 1024 + u.pn * 256 + bj * 128 + wc * 32 + n * 16 + fq * 4);
                        }
#pragma unroll
                for (int mm = 0; mm < 2; ++mm) {
                    const int m = 2 * mp + mm, row = u.pm * 256 + ai * 128 + wr * 64 + m * 16 + fr; float ss = 0.f;
#pragma unroll
                    for (int bj = 0; bj < 2; ++bj)
#pragma unroll
                        for (int n = 0; n < 2; ++n) {
                            const size_t o = (size_t)row * 1024 + u.pn * 256 + bj * 128 + wc * 32 + n * 16 + fq * 4;
                            const f32x4 v = xv[mm][bj][n] + acc[ai][bj][m][n];
                            u32x2 w; w.x = pk2(v[0], v[1]); w.y = pk2(v[2], v[3]); *(u32x2*)(HB + o) = w;
                            ss += (v[0] * v[0] + v[1] * v[1]) + (v[2] * v[2] + v[3] * v[3]);
                        }
                    ss += __shfl_xor(ss, 16); ss += __shfl_xor(ss, 32); if (fq == 0) atomicAdd(sh + row, ss);
                }
            }
    }
};

struct EpiFfnUp {
    static constexpr bool PERM = true, AFTER_DRAIN = false;
    bf16_t* ACT; const float* sh;
    DI void operator()(const AccT& acc, const Unit& u, int wr, int wc, int fr, int fq) const {
        float sv_[2][4];
#pragma unroll
        for (int ai = 0; ai < 2; ++ai)
#pragma unroll
            for (int m = 0; m < 4; ++m) sv_[ai][m] = sh[u.pm * 256 + ai * 128 + wr * 64 + m * 16 + fr];
#pragma unroll
        for (int ai = 0; ai < 2; ++ai)
#pragma unroll
            for (int m = 0; m < 4; ++m) {
                const int row = u.pm * 256 + ai * 128 + wr * 64 + m * 16 + fr;
                const float rs = rsqrtf(sv_[ai][m] * (1.0f / 1024.0f) + EPS);
#pragma unroll
                for (int bj = 0; bj < 2; ++bj) {
                    const int col0 = u.pn * 256 + bj * 128 + wc * 32 + fq * 8;
                    const f32x4 g = acc[ai][bj][m][0] * rs, uu = acc[ai][bj][m][1] * rs; f32x4 r;
#pragma unroll
                    for (int j = 0; j < 4; ++j) r[j] = g[j] * sigm(g[j]) * uu[j];
                    u32x2 w; w.x = pk2(r[0], r[1]); w.y = pk2(r[2], r[3]); *(u32x2*)(ACT + (size_t)row * DFF + (col0 >> 1)) = w;
                }
            }
    }
};

struct EpiDown {
    static constexpr bool PERM = false, AFTER_DRAIN = false;
    float* H; float* sh2; const bf16_t* HBsrc;
    DI void operator()(const AccT& acc, const Unit& u, int wr, int wc, int fr, int fq) const {
#pragma unroll
        for (int ai = 0; ai < 2; ++ai)
#pragma unroll
            for (int m = 0; m < 4; ++m) {
                const int row = u.pm * 256 + ai * 128 + wr * 64 + m * 16 + fr; float ss = 0.f;
#pragma unroll
                for (int bj = 0; bj < 2; ++bj)
#pragma unroll
                    for (int n = 0; n < 2; ++n) {
                        const size_t o = (size_t)row * 1024 + u.pn * 256 + bj * 128 + wc * 32 + n * 16 + fq * 4;
                        f32x4 hv; if (HBsrc) { const u32x2 hw = *(const u32x2*)(HBsrc + o); hv = (f32x4){bflo(hw.x), bfhi(hw.x), bflo(hw.y), bfhi(hw.y)}; } else hv = *(const f32x4*)(H + o);
                        const f32x4 v = hv + acc[ai][bj][m][n];
                        *(f32x4*)(H + o) = v; ss += (v[0] * v[0] + v[1] * v[1]) + (v[2] * v[2] + v[3] * v[3]);
                    }
                if (sh2) { ss += __shfl_xor(ss, 16); ss += __shfl_xor(ss, 32); if (fq == 0) atomicAdd(sh2 + row, ss); }
            }
    }
};


struct EpiDownNorm {
    static constexpr bool PERM = false, AFTER_DRAIN = true;
    float* Y; float* sh2; const bf16_t* HB; const float* gfin; unsigned* cnt;
    DI void fused(AccT& acc, const Unit& u, int wr, int wc, int fr, int fq, int wid, int lane) const {
#pragma unroll
        for (int ai = 0; ai < 2; ++ai) {
            u32x2 hb[4][2][2];
#pragma unroll
            for (int m = 0; m < 4; ++m)
#pragma unroll
                for (int bj = 0; bj < 2; ++bj)
#pragma unroll
                    for (int n = 0; n < 2; ++n) hb[m][bj][n] = *(const u32x2*)(HB + (size_t)(u.pm * 256 + ai * 128 + wr * 64 + m * 16 + fr) * 1024 + u.pn * 256 + bj * 128 + wc * 32 + n * 16 + fq * 4);
#pragma unroll
            for (int m = 0; m < 4; ++m) {
                const int row = u.pm * 256 + ai * 128 + wr * 64 + m * 16 + fr; float ss = 0.f;
#pragma unroll
                for (int bj = 0; bj < 2; ++bj)
#pragma unroll
                    for (int n = 0; n < 2; ++n) {
                        const u32x2 hw = hb[m][bj][n];
                        const f32x4 v = (f32x4){bflo(hw.x), bfhi(hw.x), bflo(hw.y), bfhi(hw.y)} + acc[ai][bj][m][n];
                        acc[ai][bj][m][n] = v; ss += (v[0] * v[0] + v[1] * v[1]) + (v[2] * v[2] + v[3] * v[3]);
                    }
                ss += __shfl_xor(ss, 16); ss += __shfl_xor(ss, 32); if (fq == 0) atomicAdd(sh2 + row, ss);
            }
        }
        asm volatile("s_waitcnt vmcnt(0)" ::: "memory");
        unsigned* c = cnt + 64 * u.pm;
        if (lane == 0) __hip_atomic_fetch_add(c, 1u, __ATOMIC_RELAXED, __HIP_MEMORY_SCOPE_AGENT);
        if (wid == 0) { unsigned sp = 0;
            while ((unsigned)__builtin_amdgcn_readfirstlane(__hip_atomic_load(c, __ATOMIC_RELAXED, __HIP_MEMORY_SCOPE_AGENT)) < 32u) { __builtin_amdgcn_s_sleep(2); if (++sp > (1u << 21)) break; } }
        __syncthreads();
        float sv_[2][4]; f32x4 gf[2][2];
#pragma unroll
        for (int ai = 0; ai < 2; ++ai)
#pragma unroll
            for (int m = 0; m < 4; ++m) sv_[ai][m] = __hip_atomic_load(sh2 + u.pm * 256 + ai * 128 + wr * 64 + m * 16 + fr, __ATOMIC_RELAXED, __HIP_MEMORY_SCOPE_AGENT);
#pragma unroll
        for (int bj = 0; bj < 2; ++bj)
#pragma unroll
            for (int n = 0; n < 2; ++n) gf[bj][n] = *(const f32x4*)(gfin + u.pn * 256 + bj * 128 + wc * 32 + n * 16 + fq * 4);
#pragma unroll
        for (int ai = 0; ai < 2; ++ai)
#pragma unroll
            for (int m = 0; m < 4; ++m) {
                const int row = u.pm * 256 + ai * 128 + wr * 64 + m * 16 + fr;
                const float rs = rsqrtf(sv_[ai][m] * (1.0f / 1024.0f) + EPS);
#pragma unroll
                for (int bj = 0; bj < 2; ++bj)
#pragma unroll
                    for (int n = 0; n < 2; ++n) {
                        const int col = u.pn * 256 + bj * 128 + wc * 32 + n * 16 + fq * 4;
                        *(f32x4*)(Y + (size_t)row * 1024 + col) = acc[ai][bj][m][n] * rs * gf[bj][n];
                    }
            }
    }
};

template <class Map>
DI void tr_weight(const float* W, int ldw, int K, int nrows, bf16_t* WT, const float* gk, Map map, LAS float* scr, int gw, int ngw, int lane) {
    const int nrb = nrows / 32, items = (K / 64) * nrb;
    for (int it = gw; it < items; it += ngw) {
        const int kb = it / nrb, rb = it % nrb, k0 = kb * 64, r0 = rb * 32;
        const int c = map(r0 + (lane & 31));
#pragma unroll 8
        for (int i = 0; i < 32; ++i) { const int kk = 2 * i + (lane >> 5); float v = c >= 0 ? W[(size_t)(k0 + kk) * ldw + c] : 0.f; if (gk) v *= gk[k0 + kk]; scr[kk * 33 + (lane & 31)] = v; }
        asm volatile("s_waitcnt lgkmcnt(0)" ::: "memory");
        const int cc = lane & 7;
#pragma unroll
        for (int j = 0; j < 4; ++j) { const int n = (lane >> 3) + 8 * j; const LAS float* s = scr + (8 * cc) * 33 + n;
            u32x4 o; o.x = pk2(s[0], s[33]); o.y = pk2(s[66], s[99]); o.z = pk2(s[132], s[165]); o.w = pk2(s[198], s[231]);
            *(u32x4*)(WT + (size_t)(r0 + n) * K + k0 + 8 * cc) = o; }
        asm volatile("s_waitcnt lgkmcnt(0)" ::: "memory");
    }
}
struct MapId { int off; DI int operator()(int r) const { return r + off; } };
struct MapIn { DI int operator()(int r) const {
    if (r < 2432) return r;
    if (r < 2496) { const int x = r - 2432; return 2688 + (x & 1) * 32 + (x >> 1); }
    if (r < 2560) return -1;
    if (r < 2816) return 2432 + (r - 2560);
    return r - 64; } };
struct MapUq { DI int operator()(int r) const { const int h = r / 192, d = r % 192; if (d < 128) return r; const int x = d - 128; return h * 192 + 128 + (x & 1) * 32 + (x >> 1); } };
struct MapGU { const float* dummy; DI int operator()(int r) const { return 0; } };

DI void rms_row_bf16(const float* xr, const float* g, bf16_t* orow, int lane) {
    f32x4 v[4]; float s = 0.f;
#pragma unroll
    for (int j = 0; j < 4; ++j) { v[j] = ((const f32x4*)xr)[lane + 64 * j]; s += (v[j][0] * v[j][0] + v[j][1] * v[j][1]) + (v[j][2] * v[j][2] + v[j][3] * v[j][3]); }
    const float rs = rsqrtf(wave_sum(s) * (1.0f / 1024.0f) + EPS);
#pragma unroll
    for (int j = 0; j < 4; ++j) { const f32x4 gg = ((const f32x4*)g)[lane + 64 * j]; u32x2 w; w.x = pk2(v[j][0] * rs * gg[0], v[j][1] * rs * gg[1]); w.y = pk2(v[j][2] * rs * gg[2], v[j][3] * rs * gg[3]);
        ((u32x2*)orow)[lane + 64 * j] = w; }
}

DI void rms_row2_bf16(const float* xa, const float* xb, bool hasb, const float* g, bf16_t* oa, bf16_t* ob, int lane) {
    f32x4 va[4], vb[4]; float sa = 0.f, sb = 0.f;
#pragma unroll
    for (int j = 0; j < 4; ++j) { va[j] = ((const f32x4*)xa)[lane + 64 * j]; vb[j] = hasb ? ((const f32x4*)xb)[lane + 64 * j] : (f32x4){0.f, 0.f, 0.f, 0.f}; }
    f32x4 gg[4];
#pragma unroll
    for (int j = 0; j < 4; ++j) gg[j] = ((const f32x4*)g)[lane + 64 * j];
#pragma unroll
    for (int j = 0; j < 4; ++j) { sa += (va[j][0] * va[j][0] + va[j][1] * va[j][1]) + (va[j][2] * va[j][2] + va[j][3] * va[j][3]); sb += (vb[j][0] * vb[j][0] + vb[j][1] * vb[j][1]) + (vb[j][2] * vb[j][2] + vb[j][3] * vb[j][3]); }
    const float ra = rsqrtf(wave_sum(sa) * (1.0f / 1024.0f) + EPS), rb = rsqrtf(wave_sum(sb) * (1.0f / 1024.0f) + EPS);
#pragma unroll
    for (int j = 0; j < 4; ++j) { u32x2 w; w.x = pk2(va[j][0] * ra * gg[j][0], va[j][1] * ra * gg[j][1]); w.y = pk2(va[j][2] * ra * gg[j][2], va[j][3] * ra * gg[j][3]); ((u32x2*)oa)[lane + 64 * j] = w; }
    if (hasb) {
#pragma unroll
        for (int j = 0; j < 4; ++j) { u32x2 w; w.x = pk2(vb[j][0] * rb * gg[j][0], vb[j][1] * rb * gg[j][1]); w.y = pk2(vb[j][2] * rb * gg[j][2], vb[j][3] * rb * gg[j][3]); ((u32x2*)ob)[lane + 64 * j] = w; } }
}

template <int DQK, bool MLA, bool QREG = true>
DI void attn_unit(LAS unsigned char* lds, const bf16_t* Q, int ldq, int nqv, const bf16_t* K1, int ldk1, const bf16_t* K2, const bf16_t* VT, int ldv,
                  int ntiles, int lim, int nkeys, bf16_t* O, int ldo, int tid, int wid, int lane) {
    constexpr int KS = DQK + 8, KBYTES = 64 * KS * 2, VBYTES = 128 * 136, BUF = KBYTES + VBYTES, KP = DQK / 64;
    const int r = lane & 31, h = lane >> 5;
    bf16x8 qf[QREG ? DQK / 16 : 1];
    const bf16x8 zero8 = {0, 0, 0, 0, 0, 0, 0, 0};
    const bool qok = (wid * 32 + r) < nqv; const bf16_t* qptr = Q + (size_t)(wid * 32 + r) * ldq + 8 * h;
    if (QREG) {
#pragma unroll
      for (int s = 0; s < DQK / 16; ++s) qf[QREG ? s : 0] = qok ? *(const bf16x8*)(qptr + 16 * s) : zero8; }
#define ATT_Q(s) (QREG ? qf[QREG ? (s) : 0] : (qok ? *(const bf16x8*)(qptr + 16 * (s)) : zero8))
    f32x16 o[4];
#pragma unroll
    for (int i = 0; i < 4; ++i)
#pragma unroll
        for (int j = 0; j < 16; ++j) o[i][j] = 0.f;
    float mrun = -1e30f, lrun = 0.f;
    u32x4 kreg[KP]; u32x2 vreg[4];
    const unsigned kgo1 = (unsigned)((tid >> 3) * ldk1 + (tid & 7) * 8) * 2u;
    const unsigned vgo = (unsigned)((tid >> 3) * ldv + (tid & 7) * 8) * 2u, vgs = (unsigned)ldv * 128u;
    const unsigned klo = (unsigned)((tid >> 3) * (KS * 2) + (tid & 7) * 16), vlo = (unsigned)(KBYTES + (tid >> 3) * 136 + (tid & 7) * 16);
#define ATT_LOADK(t) do { const char* k1_ = (const char*)K1 + (size_t)(t) * 128 * ldk1; const char* k2_ = (const char*)K2 + (size_t)(t) * 8192; \
    _Pragma("unroll") for (int j = 0; j < KP; ++j) { \
        if (MLA && j == 2) kreg[j] = *(const u32x4*)(k2_ + ((unsigned)tid << 4)); else kreg[j] = *(const u32x4*)(k1_ + kgo1 + j * 128); } } while (0)
#define ATT_LOADV(t) do { const char* v_ = (const char*)VT + (size_t)(t) * 128; \
    _Pragma("unroll") for (int j = 0; j < 2; ++j) { const u32x4 w = *(const u32x4*)(v_ + vgo + j * vgs); \
        vreg[2 * j] = (u32x2){w.x, w.y}; vreg[2 * j + 1] = (u32x2){w.z, w.w}; } } while (0)
#define ATT_STOREK(buf) do { LAS unsigned char* kb_ = lds + (buf) * BUF + klo; \
    _Pragma("unroll") for (int j = 0; j < KP; ++j) *(LAS u32x4*)(kb_ + j * 128) = kreg[j]; } while (0)
#define ATT_STOREV(buf) do { LAS unsigned char* vb_ = lds + (buf) * BUF + vlo; \
    _Pragma("unroll") for (int j = 0; j < 2; ++j) { *(LAS u32x2*)(vb_ + j * 64 * 136) = vreg[2 * j]; *(LAS u32x2*)(vb_ + j * 64 * 136 + 8) = vreg[2 * j + 1]; } } while (0)
#define ATT_QK() \
    _Pragma("unroll") for (int j = 0; j < 16; ++j) { s0_[j] = 0.f; s1_[j] = 0.f; } \
    _Pragma("unroll") for (int s = 0; s < DQK / 16; ++s) { \
        const bf16x8 a0_ = *(const LAS bf16x8*)(kb + r * (KS * 2) + (16 * s + 8 * h) * 2); \
        const bf16x8 a1_ = *(const LAS bf16x8*)(kb + (r + 32) * (KS * 2) + (16 * s + 8 * h) * 2); \
        const bf16x8 q_ = ATT_Q(s); \
        s0_ = __builtin_amdgcn_mfma_f32_32x32x16_bf16(a0_, q_, s0_, 0, 0, 0); \
        s1_ = __builtin_amdgcn_mfma_f32_32x32x16_bf16(a1_, q_, s1_, 0, 0, 0); }
#define ATT_SM() do { \
    if (64 * t + 64 > nkeys) { \
        _Pragma("unroll") for (int i = 0; i < 16; ++i) { const int key = 64 * t + 8 * (i >> 2) + 4 * h + (i & 3); if (key >= nkeys) s0_[i] = -1e30f; if (key + 32 >= nkeys) s1_[i] = -1e30f; } } \
    float mx = fmaxf(max16(s0_), max16(s1_)); \
    mx = fmaxf(mx, __shfl_xor(mx, 32)); \
    if (__builtin_amdgcn_ballot_w64(mx > mrun + 8.0f)) { \
        const float mnew = (mx > mrun + 8.0f) ? mx : mrun, alpha = ex2(mrun - mnew); mrun = mnew; lrun *= alpha; \
        _Pragma("unroll") for (int i = 0; i < 4; ++i) _Pragma("unroll") for (int j = 0; j < 16; ++j) o[i][j] *= alpha; } \
    float ps = 0.f; \
    _Pragma("unroll") for (int i = 0; i < 16; ++i) { s0_[i] = ex2(s0_[i] - mrun); s1_[i] = ex2(s1_[i] - mrun); ps += s0_[i] + s1_[i]; } \
    lrun += ps; \
    _Pragma("unroll") for (int q = 0; q < 2; ++q) { \
        u32x4 w0, w1; \
        w0.x = pk2(s0_[8 * q + 0], s0_[8 * q + 1]); w0.y = pk2(s0_[8 * q + 2], s0_[8 * q + 3]); w0.z = pk2(s0_[8 * q + 4], s0_[8 * q + 5]); w0.w = pk2(s0_[8 * q + 6], s0_[8 * q + 7]); \
        w1.x = pk2(s1_[8 * q + 0], s1_[8 * q + 1]); w1.y = pk2(s1_[8 * q + 2], s1_[8 * q + 3]); w1.z = pk2(s1_[8 * q + 4], s1_[8 * q + 5]); w1.w = pk2(s1_[8 * q + 6], s1_[8 * q + 7]); \
        pf_[q] = __builtin_bit_cast(bf16x8, w0); pf_[2 + q] = __builtin_bit_cast(bf16x8, w1); } } while (0)
#define ATT_PV() do { \
    _Pragma("unroll") for (int ks = 0; ks < 4; ++ks) _Pragma("unroll") for (int v4 = 0; v4 < 4; ++v4) { \
        const LAS unsigned char* vp = vb + (32 * v4 + r) * 136 + (16 * ks + 4 * h) * 2; \
        const u32x2 lo = *(const LAS u32x2*)vp, hi = *(const LAS u32x2*)(vp + 16); \
        const u32x4 aw = {lo.x, lo.y, hi.x, hi.y}; \
        o[v4] = __builtin_amdgcn_mfma_f32_32x32x16_bf16(__builtin_bit_cast(bf16x8, aw), pf_[ks], o[v4], 0, 0, 0); } } while (0)
    ATT_LOADK(0); ATT_LOADV(0); ATT_STOREK(0); ATT_STOREV(0);
    constexpr bool DEEP = MLA;
    if (DEEP && ntiles > 1) ATT_LOADK(1);
    __syncthreads();
    for (int t = 0; t < ntiles; ++t) {
        const int buf = t & 1; const bool more = t + 1 < ntiles, more2 = t + 2 < ntiles;
        const LAS unsigned char* kb = lds + buf * BUF; const LAS unsigned char* vb = kb + KBYTES;
        f32x16 s0_, s1_; bf16x8 pf_[4];
        if (!DEEP) { if (more) ATT_LOADK(t + 1); }
        if (t < lim) { ATT_QK() }
        if (more) { ATT_STOREK(buf ^ 1); ATT_LOADV(t + 1); }
        if (t < lim) ATT_SM();
        if (DEEP) { if (more2) ATT_LOADK(t + 2); }
        if (t < lim) ATT_PV();
        if (more) ATT_STOREV(buf ^ 1);
        __syncthreads();
    }
#undef ATT_QK
#undef ATT_Q
#undef ATT_SM
#undef ATT_PV
#undef ATT_LOADK
#undef ATT_LOADV
#undef ATT_STOREK
#undef ATT_STOREV
    lrun += __shfl_xor(lrun, 32);
    const float il = rcpf(lrun);
    const int t3 = lane_id();
    const int qrow = wid * 32 + (t3 & 31), h3 = t3 >> 5;
    if (lim > 0 && qrow < nqv) {
        bf16_t* op = O + (size_t)qrow * ldo + 4 * h3;
#pragma unroll
        for (int v4 = 0; v4 < 4; ++v4)
#pragma unroll
            for (int g4 = 0; g4 < 4; ++g4) {
                u32x2 w; w.x = pk2(o[v4][4 * g4] * il, o[v4][4 * g4 + 1] * il); w.y = pk2(o[v4][4 * g4 + 2] * il, o[v4][4 * g4 + 3] * il);
                *(u32x2*)(op + 32 * v4 + 8 * g4) = w;
            }
    }
}

DI void gm_unit(LAS unsigned char* lds, const bf16_t* Zrow0  , int nvalid, int gch, const bf16_t* Wsb, const float* bs, const float* gmg, const float* sv,
                bf16_t* OG  , int tid, int wid, int lane) {
    LAS unsigned char* Wl = lds; LAS unsigned char* Vt = lds + 128 * 272;
#pragma unroll
    for (int j = 0; j < 4; ++j) { const int p = tid + 512 * j, pr = p >> 4, c8 = p & 15; *(LAS u32x4*)(Wl + pr * 272 + c8 * 16) = *(const u32x4*)(Wsb + (size_t)gch * 16384 + pr * 128 + c8 * 8); }
#pragma unroll
    for (int j = 0; j < 4; ++j) {
        const int p = tid + 512 * j, q = p & 127, cg = p >> 7;
        u32x4 w = {0u, 0u, 0u, 0u}; float rs = 0.f;
        if (q < nvalid) { w = *(const u32x4*)(Zrow0 + (size_t)q * NZ + ZV + gch * 128 + cg * 8); rs = rsqrtf(sv[q] * (1.0f / 1024.0f) + EPS); }
        const f32x4 g0 = *(const f32x4*)(gmg + gch * 128 + cg * 8), g1 = *(const f32x4*)(gmg + gch * 128 + cg * 8 + 4);
        float e[8] = {bflo(w.x) * g0[0], bfhi(w.x) * g0[1], bflo(w.y) * g0[2], bfhi(w.y) * g0[3], bflo(w.z) * g1[0], bfhi(w.z) * g1[1], bflo(w.w) * g1[2], bfhi(w.w) * g1[3]};
#pragma unroll
        for (int k = 0; k < 8; ++k) { const unsigned pw = pk2(e[k] * rs, 0.f); *(LAS unsigned short*)(Vt + (cg * 8 + k) * 272 + q * 2) = (unsigned short)(pw & 0xffffu); }
    }
    __syncthreads();
    const int r = lane & 31, h = lane >> 5, cb = wid >> 1;
#pragma unroll
    for (int pi = 0; pi < 2; ++pi) {
        const int pb = 2 * (wid & 1) + pi;
        f32x16 acc;
#pragma unroll
        for (int j = 0; j < 16; ++j) acc[j] = 0.f;
        for (int ks = 0; ks < 2 * pb + 2; ++ks) {
            const bf16x8 a = *(const LAS bf16x8*)(Vt + (32 * cb + r) * 272 + (16 * ks + 8 * h) * 2);
            const bf16x8 b = *(const LAS bf16x8*)(Wl + (32 * pb + r) * 272 + (16 * ks + 8 * h) * 2);
            acc = __builtin_amdgcn_mfma_f32_32x32x16_bf16(a, b, acc, 0, 0, 0);
        }
        const int p = 32 * pb + r;
        if (p < nvalid) {
            const float bias = bs[gch * 128 + p];
            u32x2 uws[4];
#pragma unroll
            for (int g4 = 0; g4 < 4; ++g4) uws[g4] = *(const u32x2*)(Zrow0 + (size_t)p * NZ + ZU + gch * 128 + 32 * cb + 8 * g4 + 4 * h);
#pragma unroll
            for (int g4 = 0; g4 < 4; ++g4) {
                const int c = gch * 128 + 32 * cb + 8 * g4 + 4 * h;
                const u32x2 uw = uws[g4];
                u32x2 w; w.x = pk2(bflo(uw.x) * (acc[4 * g4] + bias), bfhi(uw.x) * (acc[4 * g4 + 1] + bias)); w.y = pk2(bflo(uw.y) * (acc[4 * g4 + 2] + bias), bfhi(uw.y) * (acc[4 * g4 + 3] + bias));
                *(u32x2*)(OG + (size_t)p * 1024 + c) = w;
            }
        }
    }
    __syncthreads();
}


#define XB_TMO      128
#define XB_XCNT(j)  (256  + 64 * (j))
#define XB_XSUB(j)  (1280 + 64 * (j))
#define XB_XGEN(j)  (2304 + 64 * (j))
#define XB_TOP      3328
#define XB_TOPGEN   3392
#define XCD_BAR_WORDS 3456
#define XB_SPIN_CAP (1u << 22)
DI unsigned xb_ld(unsigned* p)              { return __hip_atomic_load(p, __ATOMIC_RELAXED, __HIP_MEMORY_SCOPE_AGENT); }
DI unsigned xb_add(unsigned* p, unsigned v) { return __hip_atomic_fetch_add(p, v, __ATOMIC_RELAXED, __HIP_MEMORY_SCOPE_AGENT); }
DI unsigned xb_xcc_id() { return (unsigned)__builtin_amdgcn_s_getreg((3 << 11) | 20) & 0xFu; }
#define XB_SPIN(cond, bar) do { unsigned _sp = 0; while (cond) { __builtin_amdgcn_s_sleep(1); \
    if ((++_sp & 255u) == 0u) { if (xb_ld(&(bar)[XB_TMO])) break; if (_sp > XB_SPIN_CAP) { atomicAdd(&(bar)[XB_TMO], 1u); break; } } } } while (0)
DI void xcd_barrier_complete(unsigned* bar, unsigned x, unsigned& nloc, unsigned& nx) {
    const unsigned Gn = gridDim.x * gridDim.y * gridDim.z;
    unsigned sum, cnt, mine, sp = 0u;
    for (;;) {
        sum = 0u; cnt = 0u; mine = 0u;
#pragma unroll
        for (unsigned j = 0; j < 16; ++j) { const unsigned c = xb_ld(&bar[XB_XCNT(j)]); sum += c; cnt += (c > 0u) ? 1u : 0u; mine = (j == x) ? c : mine; }
        if (sum == Gn) break;
        __builtin_amdgcn_s_sleep(1);
        if ((++sp & 255u) == 0u) { if (xb_ld(&bar[XB_TMO])) break; if (sp > XB_SPIN_CAP) { atomicAdd(&bar[XB_TMO], 1u); break; } }
    }
    nloc = mine > 0u ? mine : 1u; nx = cnt > 0u ? cnt : 1u;
}
DI void xcd_barrier(unsigned* bar, volatile LAS unsigned* st) {
    asm volatile("s_waitcnt vmcnt(0)" ::: "memory");
    __syncthreads();
    if (threadIdx.x == 0) {
        __builtin_amdgcn_s_waitcnt(0);
        const unsigned x = xb_xcc_id();
        unsigned nloc = st[0], nx = st[1];
        if (nloc == 0u) { xcd_barrier_complete(bar, x, nloc, nx); st[0] = nloc; st[1] = nx; }
        const unsigned old = xb_add(&bar[XB_XSUB(x)], 1u);
        const unsigned gen = old / nloc;
        if (old + 1u == (gen + 1u) * nloc) {
            __builtin_amdgcn_fence(__ATOMIC_RELEASE, "agent");
            asm volatile("s_waitcnt vmcnt(0)" ::: "memory");
            const unsigned og = xb_add(&bar[XB_TOP], 1u);
            const unsigned tg = og / nx;
            if (og + 1u == (tg + 1u) * nx) xb_add(&bar[XB_TOPGEN], 1u);
            else XB_SPIN(xb_ld(&bar[XB_TOPGEN]) == tg, bar);
            __builtin_amdgcn_fence(__ATOMIC_ACQUIRE, "agent");
            xb_add(&bar[XB_XGEN(x)], 1u);
            asm volatile("s_waitcnt vmcnt(0)" ::: "memory");
        } else {
            XB_SPIN(xb_ld(&bar[XB_XGEN(x)]) == gen, bar);
            __builtin_amdgcn_fence(__ATOMIC_ACQUIRE, "agent");
            asm volatile("s_waitcnt vmcnt(0)" ::: "memory");
        }
    }
    __syncthreads();
}

struct Params { const float* in[28]; float* out; unsigned char* ws; };
typedef const Params __attribute__((address_space(4))) CParams;

__global__ void __launch_bounds__(512, 2) fwd_mega(Params P) {
    extern __shared__ __attribute__((aligned(16))) unsigned char lds_raw[];
    LAS unsigned char* lds = (LAS unsigned char*)lds_raw;
    const int G = (int)gridDim.x, bid = (int)blockIdx.x, ngw = G * 8, wid0 = __builtin_amdgcn_readfirstlane((int)threadIdx.x >> 6);
#define run_gemm(...) run_gemm_(__VA_ARGS__, wid0)
    const size_t ngt = (size_t)G * 512;
    CParams* pp; unsigned char* ws; float* out; int tid, lane, wid, gw; size_t gt;
#define PHASE_BEGIN do { pp = (CParams*)__builtin_amdgcn_kernarg_segment_ptr(); asm volatile("" : "+s"(pp)); ws = pp->ws; out = pp->out; \
    lane = lane_id(); wid = wid0; tid = wid0 * 64 + lane; gw = bid * 8 + wid; gt = (size_t)bid * 512 + tid; } while (0)
#define WSB(off) ((bf16_t*)(ws + (off)))
#define ST ((float*)(ws + WS_STAT))
#define st_v ST
#define st_q (ST + NSTAT)
#define st_kv (ST + 2 * NSTAT)
#define st_h (ST + 3 * NSTAT)
#define st_h2 (ST + 4 * NSTAT)

    volatile LAS unsigned* bst = (volatile LAS unsigned*)(lds + 131072);
    if (threadIdx.x < 4) bst[threadIdx.x] = 0u;
    __syncthreads();
    if (threadIdx.x == 0) (void)xb_add(&((unsigned*)(P.ws + WS_BAR))[XB_XCNT(xb_xcc_id())], 1u);
#define GRID_BAR() xcd_barrier((unsigned*)(ws + WS_BAR), bst)
    PHASE_BEGIN;
    {
        LAS float* scr = (LAS float*)(lds + wid * 8704);
        {
            constexpr int I_IN = 16 * 216, I_UQ = 6 * 48, I_KV4 = 4 * 128, I_WKV = 16 * 64, I_BR4 = 4 * 512, I_DN = 44 * 32, I_GU = 16 * 176, I_MV = 32 * 128;
            constexpr int TOT = I_IN + I_UQ + I_KV4 + I_WKV + I_BR4 + I_DN + I_GU + I_MV;
            for (int it0 = gw; it0 < TOT; it0 += ngw) {
                int it = it0; const float* W; const float* gk = nullptr; bf16_t* WT; int ldw, K, nrb, mapid = 0;
                if (it < I_IN) { W = pp->in[8]; ldw = 6848; K = 1024; nrb = 216; WT = WSB(WS_WIN); mapid = 1; }
                else if ((it -= I_IN) < I_UQ) { W = pp->in[13]; ldw = 1536; K = 384; nrb = 48; WT = WSB(WS_WUQ); gk = pp->in[12]; mapid = 2; }
                else if ((it -= I_UQ) < I_KV4) { const int w = it >> 7; it &= 127; W = pp->in[w < 2 ? 15 : 16]; ldw = 1024; K = 256; nrb = 32; WT = WSB(WS_WUKF) + (size_t)w * 262144; gk = (w & 1) ? nullptr : pp->in[14]; }
                else if ((it -= I_KV4) < I_WKV) { W = pp->in[18]; ldw = 2048; K = 1024; nrb = 64; WT = WSB(WS_WKV); }
                else if ((it -= I_WKV) < I_BR4) { const int w = it >> 9; it &= 511; W = pp->in[19 + w]; ldw = 1024; K = 1024; nrb = 32; WT = WSB(WS_WBG) + (size_t)w * 1048576; }
                else if ((it -= I_BR4) < I_DN) { W = pp->in[26]; ldw = 1024; K = DFF; nrb = 32; WT = WSB(WS_WDN); }
                else if ((it -= I_DN) < I_GU) { W = pp->in[24]; ldw = DFF; K = 1024; nrb = 176; WT = WSB(WS_WGU); gk = pp->in[23]; mapid = 3; }
                else { it -= I_GU; const int b = it >> 7; it &= 127; W = pp->in[5] + (size_t)b * 262144; ldw = 1024; K = 256; nrb = 32; WT = WSB(WS_MVTS) + (size_t)b * 262144; }
                const int kb = it / nrb, rb = it % nrb, k0 = kb * 64, r0 = rb * 32, dr = r0 + (lane & 31);
                int c = dr;
                if (mapid == 1) c = MapIn{}(dr); else if (mapid == 2) c = MapUq{}(dr);
                else if (mapid == 3) { const int e = dr & 7; c = 4 * (dr >> 3) + (e & 3); if (e >= 4) W = pp->in[25]; }
#pragma unroll 16
                for (int i = 0; i < 32; ++i) { const int kk = 2 * i + (lane >> 5); float v = c >= 0 ? W[(size_t)(k0 + kk) * ldw + c] : 0.f; if (gk) v *= gk[k0 + kk]; scr[kk * 33 + (lane & 31)] = v; }
                asm volatile("s_waitcnt lgkmcnt(0)" ::: "memory");
                const int cc = lane & 7;
#pragma unroll
                for (int j = 0; j < 4; ++j) { const int n = (lane >> 3) + 8 * j; const LAS float* s = scr + (8 * cc) * 33 + n;
                    u32x4 o; o.x = pk2(s[0], s[33]); o.y = pk2(s[66], s[99]); o.z = pk2(s[132], s[165]); o.w = pk2(s[198], s[231]);
                    *(u32x4*)(WT + (size_t)(r0 + n) * K + k0 + 8 * cc) = o; }
                asm volatile("s_waitcnt lgkmcnt(0)" ::: "memory");
            }
        }
        for (size_t i = gt; i < 131072; i += ngt) { const int p = (int)((i >> 7) & 127), q = (int)(i & 127); WSB(WS_WS)[i] = (bf16_t)(pk2(q <= p ? pp->in[10][i] : 0.f, 0.f) & 0xffffu); }
        for (size_t i = gt; i < (size_t)5 * NSTAT; i += ngt) ST[i] = 0.f;
        for (int m = gw; m < MG; m += 2 * ngw) rms_row2_bf16(pp->in[0] + (size_t)m * 1024, pp->in[0] + (size_t)(m + ngw) * 1024, m + ngw < MG, pp->in[7], WSB(WS_XN) + (size_t)m * 1024, WSB(WS_XN) + (size_t)(m + ngw) * 1024, lane);
        for (int m = gw; m < MS; m += ngw) rms_row_bf16(pp->in[1] + (size_t)m * 1024, pp->in[7], WSB(WS_XNS) + (size_t)m * 1024, lane);
        for (int m = gw; m < 8192; m += 2 * ngw) rms_row2_bf16(pp->in[6] + (size_t)m * 1024, pp->in[6] + (size_t)(m + ngw) * 1024, m + ngw < 8192, pp->in[17], WSB(WS_MEMN) + (size_t)m * 1024, WSB(WS_MEMN) + (size_t)(m + ngw) * 1024, lane);
        for (size_t i0 = gt; i0 < (size_t)32 * 1024 * 32; i0 += 4 * ngt) { f32x4 a[4], bb[4];
#pragma unroll
            for (int k = 0; k < 4; ++k) { const size_t i = i0 + k * ngt, row = i >> 5; const int c8 = (int)(i & 31); if (i < (size_t)32 * 1024 * 32) { a[k] = *(const f32x4*)(pp->in[2] + row * 256 + c8 * 8); bb[k] = *(const f32x4*)(pp->in[2] + row * 256 + c8 * 8 + 4); } }
#pragma unroll
            for (int k = 0; k < 4; ++k) { const size_t i = i0 + k * ngt, row = i >> 5; const int c8 = (int)(i & 31); const size_t b = row >> 10, t = row & 1023; if (i < (size_t)32 * 1024 * 32) st8(WSB(WS_CKVALL) + (b * KPAD + t) * 256 + c8 * 8, a[k], bb[k]); } }
        for (size_t i = gt; i < (size_t)32 * 48 * 32; i += ngt) { const size_t rr = i >> 5; const int c8 = (int)(i & 31); const size_t b = rr / 48, t = KALL + rr % 48;
            *(u32x4*)(WSB(WS_CKVALL) + (b * KPAD + t) * 256 + c8 * 8) = (u32x4){0u, 0u, 0u, 0u}; }
        for (size_t i = gt; i < (size_t)32 * 1024 * 8; i += ngt) { const size_t row = i >> 3; const int c8 = (int)(i & 7); const size_t b = row >> 10, t = row & 1023;
            const float* s = pp->in[3] + row * 64; const f32x4 x1 = *(const f32x4*)(s + 4 * c8), x2 = *(const f32x4*)(s + 32 + 4 * c8);
            u32x4 w; w.x = pk2(x1[0], x2[0]); w.y = pk2(x1[1], x2[1]); w.z = pk2(x1[2], x2[2]); w.w = pk2(x1[3], x2[3]);
            *(u32x4*)(WSB(WS_KRALL) + (b * KPAD + t) * 64 + c8 * 8) = w; }
        for (size_t i = gt; i < (size_t)32 * 48 * 8; i += ngt) { const size_t rr = i >> 3; const int c8 = (int)(i & 7); const size_t b = rr / 48, t = KALL + rr % 48;
            *(u32x4*)(WSB(WS_KRALL) + (b * KPAD + t) * 64 + c8 * 8) = (u32x4){0u, 0u, 0u, 0u}; }
        for (size_t i0 = gt; i0 < (size_t)8192 * 128; i0 += 4 * ngt) { f32x4 a[4], bb[4];
#pragma unroll
            for (int k = 0; k < 4; ++k) { const size_t i = i0 + k * ngt; if (i < (size_t)8192 * 128) { a[k] = *(const f32x4*)(pp->in[4] + i * 8); bb[k] = *(const f32x4*)(pp->in[4] + i * 8 + 4); } }
#pragma unroll
            for (int k = 0; k < 4; ++k) { const size_t i = i0 + k * ngt; if (i < (size_t)8192 * 128) st8(WSB(WS_MKS) + i * 8, a[k], bb[k]); } }
    }
    GRID_BAR();
    if (gridDim.x == 0x7fffffffu) cg::this_grid().sync();
    PHASE_BEGIN;

    for (int g = 0; g < NGRP; ++g) {
        const size_t r0 = (size_t)g * MG;
        {
            EpiInproj E{WSB(WS_Z), WSB(WS_KR), out + O_KRP + r0 * 64, st_v + r0, st_q + r0, st_kv + r0, SEQ, SEQ, 0, 0};
            run_gemm(lds, WSB(WS_XN), 1024, WSB(WS_WIN), 1024, MG, NZ, 1024, false, E);
        }
        if (g == 0) {
            EpiInproj E{WSB(WS_ZS), WSB(WS_KRALL), out + O_KRS, st_v + MP, st_q + MP, st_kv + MP, TS, KPAD, PAST, PAST};
            run_gemm(lds, WSB(WS_XNS), 1024, WSB(WS_WIN), 1024, MS, NZ, 1024, true, E);
            EpiMemKV E2{out + O_MKP, out + O_MVP, WSB(WS_MK)};
            run_gemm(lds, WSB(WS_MEMN), 1024, WSB(WS_WKV), 1024, 8192, 2048, 1024, false, E2);
            EpiVT E3{WSB(WS_MVT), 256, nullptr};
            run_gemm(lds, WSB(WS_WKV) + (size_t)1024 * 1024, 1024, WSB(WS_MEMN), 1024, 1024, 8192, 1024, true, E3);
        }
        if (g == 1) { EpiMerge E2{WSB(WS_ZS) + ZGA + 1024, WSB(WS_MRGS), 0}; run_gemm(lds, WSB(WS_OMS), 1024, WSB(WS_WBM), 1024, MS, 1024, 1024, true, E2); }
        if (g == 2) { EpiOut E{pp->in[1], WSB(WS_HBS), st_h + MP}; run_gemm(lds, WSB(WS_MRGS), 1024, WSB(WS_WOUT), 1024, MS, 1024, 1024, true, E); }
        if (g == 3) { EpiDown E{out + O_YS, nullptr, WSB(WS_HBS)}; run_gemm(lds, WSB(WS_ACTS), DFF, WSB(WS_WDN), DFF, MS, 1024, 1408, true, E); }
        GRID_BAR();
        PHASE_BEGIN;
        {
            EpiQ E{WSB(WS_Q), st_q + r0, SEQ, 0};
            run_gemm(lds, WSB(WS_Z) + ZCQ, NZ, WSB(WS_WUQ), 384, MG, 1536, 384, false, E);
            EpiRowScale E2{WSB(WS_KN), 1024, st_kv + r0, 1.0f / 256.0f};
            run_gemm(lds, WSB(WS_Z) + ZCKV, NZ, WSB(WS_WUKF), 256, MG, 1024, 256, false, E2);
            EpiVT E3{WSB(WS_VT), SEQ, st_kv + r0};
            run_gemm(lds, WSB(WS_WUVF), 256, WSB(WS_Z) + ZCKV, NZ, 1024, MG, 256, false, E3);
            PHASE_BEGIN;
            for (size_t i0 = gt; i0 < (size_t)MG * 32; i0 += 4 * ngt) { u32x4 wv[4]; float sv4[4];
#pragma unroll
              for (int k = 0; k < 4; ++k) { size_t i = i0 + k * ngt; if (i >= (size_t)MG * 32) i = (size_t)MG * 32 - 1; const size_t row = i >> 5; const int c8 = (int)(i & 31); wv[k] = *(const u32x4*)(WSB(WS_Z) + row * NZ + ZCKV + c8 * 8); sv4[k] = st_kv[r0 + row]; }
#pragma unroll
              for (int k = 0; k < 4; ++k) { const size_t i = i0 + k * ngt, row = i >> 5; const int c8 = (int)(i & 31); if (i < (size_t)MG * 32) {
                const u32x4 w = wv[k]; const float rs = rsqrtf(sv4[k] * (1.0f / 256.0f) + EPS);
                const f32x4 g0 = *(const f32x4*)(pp->in[14] + c8 * 8), g1 = *(const f32x4*)(pp->in[14] + c8 * 8 + 4);
                float* o = out + O_CKVP + (r0 + row) * 256 + c8 * 8;
                *(f32x4*)o = (f32x4){bflo(w.x) * rs * g0[0], bfhi(w.x) * rs * g0[1], bflo(w.y) * rs * g0[2], bfhi(w.y) * rs * g0[3]};
                *(f32x4*)(o + 4) = (f32x4){bflo(w.z) * rs * g1[0], bfhi(w.z) * rs * g1[1], bflo(w.w) * rs * g1[2], bfhi(w.w) * rs * g1[3]}; } } }
        }
        if (g == 0) {
            EpiQ E{WSB(WS_QS), st_q + MP, TS, PAST};
            run_gemm(lds, WSB(WS_ZS) + ZCQ, NZ, WSB(WS_WUQ), 384, MS, 1536, 384, true, E);
            PHASE_BEGIN;
            for (size_t i = gt; i < (size_t)MS * 32; i += ngt) { const size_t row = i >> 5; const int c8 = (int)(i & 31);
                const u32x4 w = *(const u32x4*)(WSB(WS_ZS) + row * NZ + ZCKV + c8 * 8); const float rs = rsqrtf(st_kv[MP + row] * (1.0f / 256.0f) + EPS);
                const f32x4 g0 = *(const f32x4*)(pp->in[14] + c8 * 8), g1 = *(const f32x4*)(pp->in[14] + c8 * 8 + 4);
                const f32x4 a = {bflo(w.x) * rs * g0[0], bfhi(w.x) * rs * g0[1], bflo(w.y) * rs * g0[2], bfhi(w.y) * rs * g0[3]};
                const f32x4 b = {bflo(w.z) * rs * g1[0], bfhi(w.z) * rs * g1[1], bflo(w.w) * rs * g1[2], bfhi(w.w) * rs * g1[3]};
                float* o = out + O_CKVS + row * 256 + c8 * 8; *(f32x4*)o = a; *(f32x4*)(o + 4) = b;
                st8(WSB(WS_CKVALL) + ((row >> 4) * KPAD + PAST + (row & 15)) * 256 + c8 * 8, a, b); }
            for (size_t i = gt; i < (size_t)MS * 128; i += ngt) { const size_t row = i >> 7; const int c8 = (int)(i & 127);
                const u32x4 w = *(const u32x4*)(WSB(WS_ZS) + row * NZ + ZV + c8 * 8); const float rs = rsqrtf(st_v[MP + row] * (1.0f / 1024.0f) + EPS);
                const f32x4 g0 = *(const f32x4*)(pp->in[9] + c8 * 8), g1 = *(const f32x4*)(pp->in[9] + c8 * 8 + 4);
                float* o = out + O_GVS + row * 1024 + c8 * 8;
                *(f32x4*)o = (f32x4){bflo(w.x) * rs * g0[0], bfhi(w.x) * rs * g0[1], bflo(w.y) * rs * g0[2], bfhi(w.y) * rs * g0[3]};
                *(f32x4*)(o + 4) = (f32x4){bflo(w.z) * rs * g1[0], bfhi(w.z) * rs * g1[1], bflo(w.w) * rs * g1[2], bfhi(w.w) * rs * g1[3]}; }
        }
        GRID_BAR();
        PHASE_BEGIN;
        {
            for (int u0 = bid; u0 < 256; u0 += G) {
                const int uidx = (((u0 & 7) * 8 + (u0 >> 5)) << 2) + ((u0 >> 3) & 3);
                const int bh = uidx >> 2, b = bh >> 3, hh = bh & 7;
#pragma unroll 1
                for (int half = 0; half < 2; ++half) {
                    PHASE_BEGIN;
                    const int qb = half ? 7 - (uidx & 3) : (uidx & 3);
                    const size_t rowq = (size_t)b * SEQ + qb * 256;
                    attn_unit<192, true>(lds, WSB(WS_Q) + rowq * 1536 + hh * 192, 1536, 256, WSB(WS_KN) + (size_t)b * SEQ * 1024 + hh * 128, 1024, WSB(WS_KR) + (size_t)b * SEQ * 64,
                                         WSB(WS_VT) + ((size_t)b * 1024 + hh * 128) * SEQ, SEQ, 4 * qb + 4, 4 * qb + (wid >> 1) + 1, 1 << 30,
                                         WSB(WS_OM) + rowq * 1024 + hh * 128, 1024, tid, wid, lane);
                }
            }
            PHASE_BEGIN;
            for (int u0 = bid; u0 < 512; u0 += G) {
                const int uidx = (u0 & 7) * 64 + ((u0 >> 3) & 31) + 32 * (u0 >> 8);
                const int vh = uidx & 1, qb = (uidx >> 1) & 7, hh = (uidx >> 4) & 3, b = uidx >> 6;
                const size_t rowq = (size_t)b * SEQ + qb * 256; const int bgl = g * BG + b;
                attn_unit<256, false>(lds, WSB(WS_Z) + rowq * NZ + ZQM + hh * 256, NZ, 256, WSB(WS_MK) + (size_t)bgl * 256 * 1024 + hh * 256, 1024, nullptr,
                                      WSB(WS_MVT) + ((size_t)bgl * 1024 + hh * 256 + vh * 128) * 256, 256, 4, 4, 1 << 30,
                                      WSB(WS_OE) + rowq * 1024 + hh * 256 + vh * 128, 1024, tid, wid, lane);
            }
            PHASE_BEGIN;
            for (int uidx = bid; uidx < 1024; uidx += G) {
                const int gch = uidx & 7, ch = (uidx >> 3) & 15, b = uidx >> 7; const size_t row = (size_t)b * SEQ + ch * 128;
                gm_unit(lds, WSB(WS_Z) + row * NZ, 128, gch, WSB(WS_WS), pp->in[11], pp->in[9], st_v + r0 + row, WSB(WS_OG) + row * 1024, tid, wid, lane);
            }
        }
        if (g == 0) {
            EpiRowScale E2{WSB(WS_KNS), 1024, nullptr, 0.f};
            run_gemm(lds, WSB(WS_CKVALL), 256, WSB(WS_WUKP), 256, 32 * KPAD, 1024, 256, true, E2);
            EpiVT E3{WSB(WS_VTS), KPAD, nullptr};
            run_gemm(lds, WSB(WS_WUVP), 256, WSB(WS_CKVALL), 256, 1024, 32 * KPAD, 256, true, E3);
        }
        GRID_BAR();
        PHASE_BEGIN;
        {
            EpiMerge E1{WSB(WS_Z) + ZGA, WSB(WS_MRG), 1};
            run_gemm(lds, WSB(WS_OG), 1024, WSB(WS_WBG), 1024, MG, 1024, 1024, false, E1);
            EpiMerge E2{WSB(WS_Z) + ZGA + 1024, WSB(WS_MRG), 0};
            run_gemm(lds, WSB(WS_OM), 1024, WSB(WS_WBM), 1024, MG, 1024, 1024, false, E2);
            EpiMerge E3{WSB(WS_Z) + ZGA + 2048, WSB(WS_MRG), 0};
            run_gemm(lds, WSB(WS_OE), 1024, WSB(WS_WBE), 1024, MG, 1024, 1024, false, E3);
        }
        if (g == 0) {
            PHASE_BEGIN;
            for (int uidx = G - 1 - bid; uidx < 256; uidx += G) {
                const int b = uidx >> 3, hh = uidx & 7;
                attn_unit<192, true>(lds, WSB(WS_QS) + (size_t)b * TS * 1536 + hh * 192, 1536, TS, WSB(WS_KNS) + (size_t)b * KPAD * 1024 + hh * 128, 1024, WSB(WS_KRALL) + (size_t)b * KPAD * 64,
                                     WSB(WS_VTS) + ((size_t)b * 1024 + hh * 128) * KPAD, KPAD, 17, wid == 0 ? 17 : 0, KALL,
                                     WSB(WS_OMS) + (size_t)b * TS * 1024 + hh * 128, 1024, tid, wid, lane);
            }
            for (int uidx = G - 1 - bid; uidx < 256; uidx += G) {
                const int vh = uidx & 1, hh = (uidx >> 1) & 3, b = uidx >> 3;
                attn_unit<256, false, false>(lds, WSB(WS_ZS) + (size_t)b * TS * NZ + ZQM + hh * 256, NZ, TS, WSB(WS_MKS) + (size_t)b * 256 * 1024 + hh * 256, 1024, nullptr,
                                      WSB(WS_MVTS) + ((size_t)b * 1024 + hh * 256 + vh * 128) * 256, 256, 4, wid == 0 ? 4 : 0, 1 << 30,
                                      WSB(WS_OES) + (size_t)b * TS * 1024 + hh * 256 + vh * 128, 1024, tid, wid, lane);
            }
            for (int uidx = G - 1 - bid; uidx < 256; uidx += G) {
                const int gch = uidx & 7, b = uidx >> 3; const size_t row = (size_t)b * TS;
                gm_unit(lds, WSB(WS_ZS) + row * NZ, TS, gch, WSB(WS_WS), pp->in[11], pp->in[9], st_v + MP + row, WSB(WS_OGS) + row * 1024, tid, wid, lane);
            }
        }
        GRID_BAR();
        PHASE_BEGIN;
        {
            EpiOut E{pp->in[0] + r0 * 1024, WSB(WS_HB), st_h + r0};
            run_gemm(lds, WSB(WS_MRG), 1024, WSB(WS_WOUT), 1024, MG, 1024, 1024, false, E);
        }
        GRID_BAR();
        PHASE_BEGIN;
        {
            EpiFfnUp E{WSB(WS_ACT), st_h + r0};
            run_gemm(lds, WSB(WS_HB), 1024, WSB(WS_WGU), 1024, MG, NGU, 1024, false, E);
        }
        PHASE_BEGIN;
        if (g + 1 < NGRP && bid >= G / 2) { const size_t n0 = (size_t)(g + 1) * MG;
            const int st_ = (G - G / 2) * 8;
            for (int m = (bid - G / 2) * 8 + wid; m < MG; m += 2 * st_) rms_row2_bf16(pp->in[0] + (n0 + m) * 1024, pp->in[0] + (n0 + m + st_) * 1024, m + st_ < MG, pp->in[7], WSB(WS_XN) + (size_t)m * 1024, WSB(WS_XN) + (size_t)(m + st_) * 1024, lane); }
        if (g == 0) { EpiMerge E1{WSB(WS_ZS) + ZGA, WSB(WS_MRGS), 1}; run_gemm(lds, WSB(WS_OGS), 1024, WSB(WS_WBG), 1024, MS, 1024, 1024, true, E1); }
        if (g == 1) { EpiMerge E3{WSB(WS_ZS) + ZGA + 2048, WSB(WS_MRGS), 0}; run_gemm(lds, WSB(WS_OES), 1024, WSB(WS_WBE), 1024, MS, 1024, 1024, true, E3); }
        if (g == 2) { EpiFfnUp E{WSB(WS_ACTS), st_h + MP}; run_gemm(lds, WSB(WS_HBS), 1024, WSB(WS_WGU), 1024, MS, NGU, 1024, true, E); }
        if (g == 3) { EpiDown E{out + O_YS, st_h2 + MP, nullptr}; run_gemm(lds, WSB(WS_ACTS) + 1408, DFF, WSB(WS_WDN) + 1408, DFF, MS, 1024, 1408, true, E); }
        GRID_BAR();
        PHASE_BEGIN;
        {
            EpiDownNorm E{out + O_YP + r0 * 1024, st_h2 + r0, WSB(WS_HB), pp->in[27], (unsigned*)(ws + WS_BAR) + 4096 + 4096 * g};
            run_gemm(lds, WSB(WS_ACT), DFF, WSB(WS_WDN), DFF, MG, 1024, DFF, false, E);
        }
        PHASE_BEGIN;
    }
    {
        const size_t p0 = (size_t)(NGRP - 1) * MG;
        (void)p0;
        for (int m = gw; m < MS; m += ngw) {
            float* hr = out + O_YS + (size_t)m * 1024; const float ssq = st_h2[MP + m];
            const float rs = rsqrtf(ssq * (1.0f / 1024.0f) + EPS);
#pragma unroll
            for (int j = 0; j < 4; ++j) { const f32x4 gg = ((const f32x4*)pp->in[27])[lane + 64 * j]; f32x4 v = ((f32x4*)hr)[lane + 64 * j]; ((f32x4*)hr)[lane + 64 * j] = v * rs * gg; }
        }
    }
}

extern "C" void kernel_launch(void* const* d_in, const int* in_sizes, int n_in, void* d_out, int out_size, void* d_ws, size_t ws_size, hipStream_t stream) {
    static int grid = 0;
    if (grid == 0) {
        if (n_in != 28 || ws_size < WS_END) { fprintf(stderr, "kernel_launch: need 28 inputs and %zu bytes of workspace (got %d, %zu)\n", (size_t)WS_END, n_in, ws_size); grid = -1; return; }
        int dev = 0, cus = 0, per_cu = 0;
        hipGetDevice(&dev); hipDeviceGetAttribute(&cus, hipDeviceAttributeMultiprocessorCount, dev);
        if (hipFuncSetAttribute((const void*)fwd_mega, hipFuncAttributeMaxDynamicSharedMemorySize, LDS_BYTES) != hipSuccess) fprintf(stderr, "kernel_launch: hipFuncSetAttribute failed\n");
        if (hipOccupancyMaxActiveBlocksPerMultiprocessor(&per_cu, (const void*)fwd_mega, 512, LDS_BYTES) != hipSuccess || per_cu < 1) { fprintf(stderr, "kernel_launch: occupancy query says %d\n", per_cu); per_cu = 1; }
        (void)hipGetLastError();
        grid = cus > 0 ? cus : 256;
        if (grid != 256) fprintf(stderr, "kernel_launch: built for 256 CUs (got %d): the fused final norm needs one unit per workgroup\n", grid);
    }
    if (grid < 0) return;
    Params p{};
    for (int i = 0; i < 28; ++i) p.in[i] = (const float*)d_in[i];
    p.out = (float*)d_out; p.ws = (unsigned char*)d_ws;
    (void)hipMemsetAsync((char*)d_ws + WS_BAR, 0, 131072, stream);
    void* args[] = {&p};
    hipError_t e = hipLaunchCooperativeKernel((const void*)fwd_mega, dim3(grid), dim3(512), args, LDS_BYTES, stream);
    if (e != hipSuccess) fprintf(stderr, "cooperative launch failed: %s (grid %d)\n", hipGetErrorString(e), grid);
}
```

```cpp
#include <hip/hip_runtime.h>
#include <hip/hip_cooperative_groups.h>
#include <cstdio>
namespace cg = cooperative_groups;

#define LAS __attribute__((address_space(3)))
#define DI __device__ __forceinline__
typedef unsigned short bf16_t;
typedef short bf16x8 __attribute__((ext_vector_type(8)));
typedef float f32x4 __attribute__((ext_vector_type(4)));
typedef float f32x16 __attribute__((ext_vector_type(16)));
typedef unsigned u32x4 __attribute__((ext_vector_type(4)));
typedef unsigned u32x2 __attribute__((ext_vector_type(2)));
typedef __bf16 bfv2 __attribute__((ext_vector_type(2)));
typedef float fv2 __attribute__((ext_vector_type(2)));

constexpr int D = 1024, SEQ = 2048, MP = 65536, MS = 512, TS = 16, PAST = 1024, KALL = 1040, KPAD = 1088;
constexpr int NGRP = 4, MG = MP / NGRP, BG = 32 / NGRP;
constexpr int NZ = 6912;
constexpr int ZU = 0, ZV = 1024, ZCQ = 2048, ZKR = 2432, ZCKV = 2560, ZQM = 2816, ZGA = 3840;
constexpr int DFF = 2816, NGU = 5632;
constexpr float EPS = 1e-6f;
constexpr float LOG2E = 1.4426950408889634f;
constexpr float QSCALE = 0.07216878364870322f * LOG2E;
constexpr float MSCALE = 0.0625f * LOG2E;
constexpr int NSTAT = MP + MS;

constexpr size_t O_YP = 0, O_YS = 67108864, O_CKVP = 67633152, O_KRP = 84410368, O_MKP = 88604672, O_MVP = 96993280,
                 O_CKVS = 105381888, O_KRS = 105512960, O_GVS = 105545728;

constexpr size_t al256(size_t x) { return (x + 255) & ~(size_t)255; }
constexpr size_t WS_WIN = 0;
constexpr size_t WS_WUQ = WS_WIN + al256((size_t)NZ * 1024 * 2);
constexpr size_t WS_WUKF = WS_WUQ + al256((size_t)1536 * 384 * 2);
constexpr size_t WS_WUKP = WS_WUKF + 524288;
constexpr size_t WS_WUVF = WS_WUKP + 524288;
constexpr size_t WS_WUVP = WS_WUVF + 524288;
constexpr size_t WS_WKV = WS_WUVP + 524288;
constexpr size_t WS_WBG = WS_WKV + (size_t)2048 * 1024 * 2;
constexpr size_t WS_WBM = WS_WBG + 2097152;
constexpr size_t WS_WBE = WS_WBM + 2097152;
constexpr size_t WS_WOUT = WS_WBE + 2097152;
constexpr size_t WS_WGU = WS_WOUT + 2097152;
constexpr size_t WS_WDN = WS_WGU + (size_t)NGU * 1024 * 2;
constexpr size_t WS_WS = WS_WDN + (size_t)1024 * DFF * 2;
constexpr size_t WS_STAT = WS_WS + 262144;
constexpr size_t WS_BAR = WS_STAT + al256((size_t)5 * NSTAT * 4);
constexpr size_t WS_MEMN = WS_BAR + 131072;
constexpr size_t WS_MK = WS_MEMN + (size_t)8192 * 1024 * 2;
constexpr size_t WS_MVT = WS_MK + (size_t)8192 * 1024 * 2;
constexpr size_t WS_XN = WS_MVT + (size_t)8192 * 1024 * 2;
constexpr size_t WS_Z = WS_XN + (size_t)MG * 1024 * 2;
constexpr size_t WS_Q = WS_Z + (size_t)MG * NZ * 2;
constexpr size_t WS_KN = WS_Q + (size_t)MG * 1536 * 2;
constexpr size_t WS_VT = WS_KN + (size_t)MG * 1024 * 2;
constexpr size_t WS_KR = WS_VT + (size_t)MG * 1024 * 2;
constexpr size_t WS_OG = WS_KR + (size_t)MG * 64 * 2;
constexpr size_t WS_OM = WS_OG + (size_t)MG * 1024 * 2;
constexpr size_t WS_OE = WS_OM + (size_t)MG * 1024 * 2;
constexpr size_t WS_MRG = WS_OE + (size_t)MG * 1024 * 2;
constexpr size_t WS_HB = WS_MRG + (size_t)MG * 1024 * 2;
constexpr size_t WS_ACT = WS_HB + (size_t)MG * 1024 * 2;
constexpr size_t WS_XNS = WS_ACT + (size_t)MG * DFF * 2;
constexpr size_t WS_ZS = WS_XNS + (size_t)MS * 1024 * 2;
constexpr size_t WS_QS = WS_ZS + (size_t)MS * NZ * 2;
constexpr size_t WS_CKVALL = WS_QS + (size_t)MS * 1536 * 2;
constexpr size_t WS_KRALL = WS_CKVALL + (size_t)32 * KPAD * 256 * 2;
constexpr size_t WS_KNS = WS_KRALL + (size_t)32 * KPAD * 64 * 2;
constexpr size_t WS_VTS = WS_KNS + (size_t)32 * KPAD * 1024 * 2;
constexpr size_t WS_MKS = WS_VTS + (size_t)32 * KPAD * 1024 * 2;
constexpr size_t WS_MVTS = WS_MKS + (size_t)8192 * 1024 * 2;
constexpr size_t WS_OGS = WS_MVTS + (size_t)8192 * 1024 * 2;
constexpr size_t WS_OMS = WS_OGS + (size_t)MS * 1024 * 2;
constexpr size_t WS_OES = WS_OMS + (size_t)MS * 1024 * 2;
constexpr size_t WS_MRGS = WS_OES + (size_t)MS * 1024 * 2;
constexpr size_t WS_HBS = WS_MRGS + (size_t)MS * 1024 * 2;
constexpr size_t WS_ACTS = WS_HBS + (size_t)MS * 1024 * 2;
constexpr size_t WS_END = WS_ACTS + (size_t)MS * DFF * 2;
static_assert((size_t)MG * DFF * 2 <= (size_t)MG * NZ * 2, "ACT aliases Z");
static_assert(WS_END <= (size_t)1000 * 1024 * 1024, "workspace");

constexpr int LDS_BYTES = 135168;

DI unsigned pk2(float lo, float hi) { fv2 v = {lo, hi}; return __builtin_bit_cast(unsigned, __builtin_convertvector(v, bfv2)); }
DI float bflo(unsigned w) { return __uint_as_float(w << 16); }
DI float bfhi(unsigned w) { return __uint_as_float(w & 0xffff0000u); }
DI float ex2(float x) { return __builtin_amdgcn_exp2f(x); }
DI float rcpf(float x) { return __builtin_amdgcn_rcpf(x); }
DI float sigm(float x) { return rcpf(1.0f + ex2(-x * LOG2E)); }
DI float gelu_t(float x) { const float t = x * (1.0f + 0.044715f * x * x) * 2.3022081985f; return x * rcpf(1.0f + ex2(-t)); }
DI float max16(const f32x16& x) { float r;
    asm volatile("s_nop 15\n\tv_max3_f32 %0, %1, %2, %3\n\tv_max3_f32 %0, %0, %4, %5\n\tv_max3_f32 %0, %0, %6, %7\n\tv_max3_f32 %0, %0, %8, %9\n\tv_max3_f32 %0, %0, %10, %11\n\tv_max3_f32 %0, %0, %12, %13\n\tv_max3_f32 %0, %0, %14, %15\n\tv_max_f32 %0, %0, %16"
                 : "=&v"(r) : "v"(x[0]), "v"(x[1]), "v"(x[2]), "v"(x[3]), "v"(x[4]), "v"(x[5]), "v"(x[6]), "v"(x[7]), "v"(x[8]), "v"(x[9]), "v"(x[10]), "v"(x[11]), "v"(x[12]), "v"(x[13]), "v"(x[14]), "v"(x[15]));
    return r; }
DI int lane_id() { int l; asm volatile("v_mbcnt_lo_u32_b32 %0, -1, 0\n\tv_mbcnt_hi_u32_b32 %0, -1, %0" : "=v"(l)); return l; }
DI float wave_sum(float v) {
#pragma unroll
    for (int o = 1; o < 64; o <<= 1) v += __shfl_xor(v, o);
    return v;
}
DI void rope_pair(float x1, float x2, int i, float pos, float& y1, float& y2) {
    const float inv = ex2(-(float)i * 0.41524101186092029f);
    const float rev = pos * inv * 0.15915494309189535f;
    const float fr = rev - floorf(rev);
    const float s = __builtin_amdgcn_sinf(fr), c = __builtin_amdgcn_cosf(fr);
    y1 = x1 * c - x2 * s; y2 = x1 * s + x2 * c;
}

namespace pg8 {
constexpr int BM = 256, BK = 64, HALF = 128, HTB = HALF * BK * 2, STAGE_BYTES = 8 * HTB, NXCD = 8, WGM = 8;
DI int lds_byte(int r, int c) { const int st = (r >> 4) * 2 + (c >> 5), rr = r & 15, cc = c & 31, ob = rr * 64 + cc * 2; return st * 1024 + (ob ^ (((ob >> 9) & 1) << 5)); }
DI void stage_rc(int b, int& R, int& C) { const int st = b / 1024, sb = b % 1024, swz = sb ^ (((sb >> 9) & 1) << 5); R = (st >> 1) * 16 + swz / 64; C = (st & 1) * 32 + (swz % 64) / 2; }
DI int perm32(int rho) { const int n = rho >> 4, i = rho & 15; return 8 * (i >> 2) + 4 * n + (i & 3); }
struct Unit { int pm, pn; };
struct Gemm { const bf16_t* A; const bf16_t* Bt; int M, N, K, lda, ldb; };
struct StaticOrder {
    int nM, nN, nwg, G, c;
    DI void init(int M, int N, int G_, int c_) { nM = M / BM; nN = N / BM; nwg = nM * nN; G = G_; c = c_; }
    DI bool next(int i, Unit& u) const {
        const long L = (long)i * G + c; if (L >= nwg) return false;
        int wgid = (int)L; { const int q = nwg / NXCD, r = nwg % NXCD, xcd = wgid % NXCD, off = wgid / NXCD; wgid = (xcd < r ? xcd * (q + 1) : r * (q + 1) + (xcd - r) * q) + off; }
        const int nig = WGM * nN, gid = wgid / nig, fm = gid * WGM, gsz = (nM - fm) < WGM ? (nM - fm) : WGM;
        u.pm = fm + ((wgid % nig) % gsz); u.pn = (wgid % nig) / gsz; return true;
    }
};

template <class Epi>
DI void gemm_phase(LAS unsigned char* lds, const Gemm g, const StaticOrder& S, const Epi& E, const int tid) {
    const int wid = __builtin_amdgcn_readfirstlane(tid >> 6), lane = tid & 63, wr = wid >> 2, wc = wid & 3, fr = lane & 15, fq = lane >> 4;
    const int K = g.K, nt = K / BK;
    unsigned voffA, voffB; const unsigned vstoffA = (unsigned)g.lda * 128u, vstoffB = (unsigned)g.ldb * 128u;
    { int R, C; stage_rc(tid * 16, R, C); const int Rb = Epi::PERM ? ((R & ~31) + perm32(R & 31)) : R;
        voffA = (unsigned)(R * g.lda + C) * 2u; voffB = (unsigned)(Rb * g.ldb + C) * 2u; }
    const size_t kstep = (size_t)(BK * 2);
    const size_t hsA = (size_t)HALF * g.lda * 2, hsB = (size_t)HALF * g.ldb * 2;
    const size_t tsA = 2 * hsA, tsB = 2 * hsB;
    const unsigned ldsw = (unsigned)wid * 1024u;
    const int aoff = lds_byte(wr * 64 + fr, fq * 8), boff = lds_byte(wc * 32 + fr, fq * 8);
#define PG8_SA(b, h) (((b) * 2 + (h)) * HTB)
#define PG8_SB(b, h) ((4 + (b) * 2 + (h)) * HTB)
#define PG8_STAGE(bufoff, gbase, voff) do { _Pragma("unroll") for (int _i = 0; _i < 2; ++_i) \
        __builtin_amdgcn_global_load_lds((const unsigned*)((const char*)(gbase) + (size_t)_i * vst##voff + v##voff), (LAS unsigned*)(lds + (bufoff) + ldsw + _i * 8192), 16, 0, 0); } while (0)
#define PG8_LDA(dst, b, h) do { _Pragma("unroll") for (int m = 0; m < 4; ++m) _Pragma("unroll") for (int k = 0; k < 2; ++k) dst[m][k] = *(const LAS bf16x8*)(lds + PG8_SA(b, h) + aoff + m * 2048 + k * 1024); } while (0)
#define PG8_LDB(dst, b, h) do { _Pragma("unroll") for (int n = 0; n < 2; ++n) _Pragma("unroll") for (int k = 0; k < 2; ++k) dst[n][k] = *(const LAS bf16x8*)(lds + PG8_SB(b, h) + boff + n * 2048 + k * 1024); } while (0)
#define PG8_MMA(ai, bj, At, Bt) do { __builtin_amdgcn_s_setprio(1); _Pragma("unroll") for (int m = 0; m < 4; ++m) _Pragma("unroll") for (int n = 0; n < 2; ++n) _Pragma("unroll") for (int k = 0; k < 2; ++k) \
        acc[ai][bj][m][n] = __builtin_amdgcn_mfma_f32_16x16x32_bf16(Bt[n][k], At[m][k], acc[ai][bj][m][n], 0, 0, 0); __builtin_amdgcn_s_setprio(0); } while (0)
#define PG8_WAIT_V(n) asm volatile("s_waitcnt vmcnt(" #n ")" ::: "memory")
#define PG8_WAIT_L(n) asm volatile("s_waitcnt lgkmcnt(" #n ")" ::: "memory")
#define PG8_BAR __builtin_amdgcn_s_barrier()
#define PG8_SCHED __builtin_amdgcn_sched_barrier(0)
    Unit cur, nxt; int ui = 0;
    if (!S.next(0, cur)) return;
    f32x4 acc[2][2][4][2];
#pragma unroll
    for (int a = 0; a < 2; ++a)
#pragma unroll
        for (int b = 0; b < 2; ++b)
#pragma unroll
            for (int m = 0; m < 4; ++m)
#pragma unroll
                for (int n = 0; n < 2; ++n) acc[a][b][m][n] = (f32x4){0.f, 0.f, 0.f, 0.f};
    bf16x8 At[4][2], B0[2][2], B1[2][2];
    const char* cA = (const char*)g.A + (size_t)cur.pm * tsA; const char* cB = (const char*)g.Bt + (size_t)cur.pn * tsB;
    PG8_STAGE(PG8_SB(0, 0), cB, offB); PG8_STAGE(PG8_SA(0, 0), cA, offA); PG8_STAGE(PG8_SB(0, 1), cB + hsB, offB); PG8_STAGE(PG8_SA(0, 1), cA + hsA, offA);
    if (wr == 1) PG8_BAR;
    PG8_WAIT_V(4); PG8_BAR;
    PG8_STAGE(PG8_SB(1, 0), cB + kstep, offB); PG8_STAGE(PG8_SA(1, 0), cA + kstep, offA); PG8_STAGE(PG8_SB(1, 1), cB + hsB + kstep, offB);
    PG8_WAIT_V(6); PG8_BAR;
    for (;;) {
        const bool has_next = S.next(ui + 1, nxt);
        const char* nA = has_next ? (const char*)g.A + (size_t)nxt.pm * tsA : cA; const char* nB = has_next ? (const char*)g.Bt + (size_t)nxt.pn * tsB : cB;
        for (int t = 0; t < nt; t += 2) {
            const bool last = (t == nt - 2);
            const char* a1 = cA + (size_t)(t + 1) * kstep;
            const char* a2 = last ? nA : cA + (size_t)(t + 2) * kstep; const char* b2 = last ? nB : cB + (size_t)(t + 2) * kstep;
            const char* a3 = a2 + kstep; const char* b3 = b2 + kstep;
            PG8_LDB(B0, 0, 0); PG8_SCHED; PG8_LDA(At, 0, 0); PG8_STAGE(PG8_SA(1, 1), a1 + hsA, offA);
            PG8_WAIT_L(8); PG8_BAR; PG8_WAIT_L(0); PG8_MMA(0, 0, At, B0); PG8_BAR; PG8_SCHED;
            PG8_LDB(B1, 0, 1); PG8_STAGE(PG8_SB(0, 0), b2, offB);
            PG8_BAR; PG8_WAIT_L(0); PG8_MMA(0, 1, At, B1); PG8_BAR;
            PG8_LDA(At, 0, 1); PG8_STAGE(PG8_SA(0, 0), a2, offA);
            PG8_BAR; PG8_WAIT_L(0); PG8_MMA(1, 0, At, B0); PG8_BAR; PG8_SCHED;
            PG8_STAGE(PG8_SB(0, 1), b2 + hsB, offB);
            PG8_WAIT_V(6); PG8_BAR; PG8_MMA(1, 1, At, B1); PG8_BAR;
            PG8_LDB(B0, 1, 0); PG8_SCHED; PG8_LDA(At, 1, 0); PG8_STAGE(PG8_SA(0, 1), a2 + hsA, offA);
            PG8_WAIT_L(8); PG8_BAR; PG8_WAIT_L(0); PG8_MMA(0, 0, At, B0); PG8_BAR; PG8_SCHED;
            PG8_LDB(B1, 1, 1); PG8_STAGE(PG8_SB(1, 0), b3, offB);
            PG8_BAR; PG8_WAIT_L(0); PG8_MMA(0, 1, At, B1); PG8_BAR;
            PG8_LDA(At, 1, 1); PG8_STAGE(PG8_SA(1, 0), a3, offA);
            PG8_BAR; PG8_WAIT_L(0); PG8_MMA(1, 0, At, B0); PG8_BAR; PG8_SCHED;
            PG8_STAGE(PG8_SB(1, 1), b3 + hsB, offB);
            PG8_WAIT_V(6); PG8_BAR; PG8_MMA(1, 1, At, B1); PG8_BAR;
        }
        if constexpr (!Epi::AFTER_DRAIN) { const int t2 = lane_id(); E(acc, cur, wr, wc, t2 & 15, t2 >> 4); }
        if (!has_next) break;
#pragma unroll
        for (int a = 0; a < 2; ++a)
#pragma unroll
            for (int b = 0; b < 2; ++b)
#pragma unroll
                for (int m = 0; m < 4; ++m)
#pragma unroll
                    for (int n = 0; n < 2; ++n) acc[a][b][m][n] = (f32x4){0.f, 0.f, 0.f, 0.f};
        cur = nxt; cA = nA; cB = nB; ++ui;
    }
    PG8_WAIT_V(0);
    if (wr == 0) PG8_BAR;
    PG8_BAR;
    if constexpr (Epi::AFTER_DRAIN) { const int t2 = lane_id(); E.fused(acc, cur, wr, wc, t2 & 15, t2 >> 4, wid, t2); }
#undef PG8_SA
#undef PG8_SB
#undef PG8_STAGE
#undef PG8_LDA
#undef PG8_LDB
#undef PG8_MMA
#undef PG8_WAIT_V
#undef PG8_WAIT_L
#undef PG8_BAR
#undef PG8_SCHED
}
}
using pg8::Unit;
typedef f32x4 AccT[2][2][4][2];

template <class Epi>
DI void run_gemm_(LAS unsigned char* lds, const bf16_t* A, int lda, const bf16_t* Bt, int ldb, int M, int N, int K, bool rev, const Epi& E, int wid0) {
    pg8::Gemm g{A, Bt, M, N, K, lda, ldb}; pg8::StaticOrder S; const int G = (int)gridDim.x;
    const int bx_ = (G == 256) ? (((int)blockIdx.x & 31) * 8 + ((int)blockIdx.x >> 5)) : (int)blockIdx.x;
    S.init(M, N, G, rev ? G - 1 - bx_ : bx_);
    const int tidv = wid0 * 64 + lane_id();
    pg8::gemm_phase<Epi>(lds, g, S, E, tidv);
}

DI void st8(bf16_t* p, f32x4 a, f32x4 b) { u32x4 w; w.x = pk2(a[0], a[1]); w.y = pk2(a[2], a[3]); w.z = pk2(b[0], b[1]); w.w = pk2(b[2], b[3]); *(u32x4*)p = w; }

struct EpiInproj {
    static constexpr bool PERM = true, AFTER_DRAIN = false;
    bf16_t* Z; bf16_t* KR; float* krout; float* sv; float* sq; float* skv; int T, Tpad, off, pos0;
    DI void operator()(const AccT& acc, const Unit& u, int wr, int wc, int fr, int fq) const {
        const int pn = u.pn;
        float* stp = (pn >= 4 && pn < 8) ? sv : ((pn == 8 || pn == 9) ? sq : (pn == 10 ? skv : nullptr));
#pragma unroll
        for (int ai = 0; ai < 2; ++ai)
#pragma unroll
            for (int m = 0; m < 4; ++m) {
                const int row = u.pm * 256 + ai * 128 + wr * 64 + m * 16 + fr;
                float ss = 0.f;
#pragma unroll
                for (int bj = 0; bj < 2; ++bj) {
                    f32x4 a = acc[ai][bj][m][0], b = acc[ai][bj][m][1];
                    const int col0 = pn * 256 + bj * 128 + wc * 32 + fq * 8;
                    if (pn == 9 && bj == 1) {
                        if (wc >= 2) continue;
                        const int kc = wc * 32 + fq * 8, i0 = kc >> 1; const float pos = (float)(pos0 + (row % T));
                        f32x4 y1, y2; float p, q;
                        rope_pair(a[0], a[1], i0 + 0, pos, p, q); y1[0] = p; y2[0] = q;
                        rope_pair(a[2], a[3], i0 + 1, pos, p, q); y1[1] = p; y2[1] = q;
                        rope_pair(b[0], b[1], i0 + 2, pos, p, q); y1[2] = p; y2[2] = q;
                        rope_pair(b[2], b[3], i0 + 3, pos, p, q); y1[3] = p; y2[3] = q;
                        *(f32x4*)(krout + (size_t)row * 64 + i0) = y1; *(f32x4*)(krout + (size_t)row * 64 + 32 + i0) = y2;
                        const size_t dr = (size_t)(row / T) * Tpad + off + (row % T);
                        u32x4 w; w.x = pk2(y1[0], y2[0]); w.y = pk2(y1[1], y2[1]); w.z = pk2(y1[2], y2[2]); w.w = pk2(y1[3], y2[3]);
                        *(u32x4*)(KR + dr * 64 + kc) = w;
                        continue;
                    }
                    if (pn < 8) {
#pragma unroll
                        for (int j = 0; j < 4; ++j) { a[j] = gelu_t(a[j]); b[j] = gelu_t(b[j]); }
                    } else if (pn >= 15) {
#pragma unroll
                        for (int j = 0; j < 4; ++j) { a[j] = sigm(a[j]); b[j] = sigm(b[j]); }
                    } else if (pn >= 11) { a = a * MSCALE; b = b * MSCALE; }
                    ss += (a[0] * a[0] + a[1] * a[1]) + (a[2] * a[2] + a[3] * a[3]) + (b[0] * b[0] + b[1] * b[1]) + (b[2] * b[2] + b[3] * b[3]);
                    st8(Z + (size_t)row * NZ + col0, a, b);
                }
                if (stp) { ss += __shfl_xor(ss, 16); ss += __shfl_xor(ss, 32); if (fq == 0) atomicAdd(stp + row, ss); }
            }
    }
};

struct EpiQ {
    static constexpr bool PERM = true, AFTER_DRAIN = false;
    bf16_t* Q; const float* sq; int T, pos0;
    DI void operator()(const AccT& acc, const Unit& u, int wr, int wc, int fr, int fq) const {
        float sv_[2][4];
#pragma unroll
        for (int ai = 0; ai < 2; ++ai)
#pragma unroll
            for (int m = 0; m < 4; ++m) sv_[ai][m] = sq[u.pm * 256 + ai * 128 + wr * 64 + m * 16 + fr];
#pragma unroll
        for (int ai = 0; ai < 2; ++ai)
#pragma unroll
            for (int m = 0; m < 4; ++m) {
                const int row = u.pm * 256 + ai * 128 + wr * 64 + m * 16 + fr;
                const float rs = rsqrtf(sv_[ai][m] * (1.0f / 384.0f) + EPS) * QSCALE; const float pos = (float)(pos0 + (row % T));
#pragma unroll
                for (int bj = 0; bj < 2; ++bj) {
                    f32x4 a = acc[ai][bj][m][0] * rs, b = acc[ai][bj][m][1] * rs;
                    const int col0 = u.pn * 256 + bj * 128 + wc * 32 + fq * 8, d = col0 % 192;
                    if (d >= 128) { const int i0 = (d - 128) >> 1; float p, q;
                        rope_pair(a[0], a[1], i0 + 0, pos, p, q); a[0] = p; a[1] = q;
                        rope_pair(a[2], a[3], i0 + 1, pos, p, q); a[2] = p; a[3] = q;
                        rope_pair(b[0], b[1], i0 + 2, pos, p, q); b[0] = p; b[1] = q;
                        rope_pair(b[2], b[3], i0 + 3, pos, p, q); b[2] = p; b[3] = q; }
                    st8(Q + (size_t)row * 1536 + col0, a, b);
                }
            }
    }
};

struct EpiRowScale {
    static constexpr bool PERM = true, AFTER_DRAIN = false;
    bf16_t* O; int ldc; const float* st; float invn;
    DI void operator()(const AccT& acc, const Unit& u, int wr, int wc, int fr, int fq) const {
        float sv_[2][4];
#pragma unroll
        for (int ai = 0; ai < 2; ++ai)
#pragma unroll
            for (int m = 0; m < 4; ++m) sv_[ai][m] = st ? st[u.pm * 256 + ai * 128 + wr * 64 + m * 16 + fr] : 0.f;
#pragma unroll
        for (int ai = 0; ai < 2; ++ai)
#pragma unroll
            for (int m = 0; m < 4; ++m) {
                const int row = u.pm * 256 + ai * 128 + wr * 64 + m * 16 + fr;
                const float rs = st ? rsqrtf(sv_[ai][m] * invn + EPS) : 1.0f;
#pragma unroll
                for (int bj = 0; bj < 2; ++bj) st8(O + (size_t)row * ldc + u.pn * 256 + bj * 128 + wc * 32 + fq * 8, acc[ai][bj][m][0] * rs, acc[ai][bj][m][1] * rs);
            }
    }
};

struct EpiVT {
    static constexpr bool PERM = true, AFTER_DRAIN = false;
    bf16_t* O; int Tk; const float* st;
    DI void operator()(const AccT& acc, const Unit& u, int wr, int wc, int fr, int fq) const {
        f32x4 sa[2][2];
#pragma unroll
        for (int bj = 0; bj < 2; ++bj) { const int c0 = u.pn * 256 + bj * 128 + wc * 32 + fq * 8;
            sa[bj][0] = st ? *(const f32x4*)(st + c0) : (f32x4){0.f, 0.f, 0.f, 0.f}; sa[bj][1] = st ? *(const f32x4*)(st + c0 + 4) : (f32x4){0.f, 0.f, 0.f, 0.f}; }
#pragma unroll
        for (int bj = 0; bj < 2; ++bj) {
            const int c0 = u.pn * 256 + bj * 128 + wc * 32 + fq * 8, b = c0 / Tk, key = c0 % Tk;
            f32x4 r0 = {1.f, 1.f, 1.f, 1.f}, r1 = r0;
            if (st) { const f32x4 s0 = sa[bj][0], s1 = sa[bj][1];
#pragma unroll
                for (int j = 0; j < 4; ++j) { r0[j] = rsqrtf(s0[j] * (1.0f / 256.0f) + EPS); r1[j] = rsqrtf(s1[j] * (1.0f / 256.0f) + EPS); } }
#pragma unroll
            for (int ai = 0; ai < 2; ++ai)
#pragma unroll
                for (int m = 0; m < 4; ++m) {
                    const int f = u.pm * 256 + ai * 128 + wr * 64 + m * 16 + fr;
                    st8(O + ((size_t)b * 1024 + f) * Tk + key, acc[ai][bj][m][0] * r0, acc[ai][bj][m][1] * r1);
                }
        }
    }
};

struct EpiMemKV {
    static constexpr bool PERM = false, AFTER_DRAIN = false;
    float* outK; float* outV; bf16_t* MK;
    DI void operator()(const AccT& acc, const Unit& u, int wr, int wc, int fr, int fq) const {
#pragma unroll
        for (int ai = 0; ai < 2; ++ai)
#pragma unroll
            for (int m = 0; m < 4; ++m) {
                const int row = u.pm * 256 + ai * 128 + wr * 64 + m * 16 + fr;
#pragma unroll
                for (int bj = 0; bj < 2; ++bj)
#pragma unroll
                    for (int n = 0; n < 2; ++n) {
                        const int col = u.pn * 256 + bj * 128 + wc * 32 + n * 16 + fq * 4; const f32x4 v = acc[ai][bj][m][n];
                        if (u.pn < 4) { *(f32x4*)(outK + (size_t)row * 1024 + col) = v; u32x2 w; w.x = pk2(v[0], v[1]); w.y = pk2(v[2], v[3]); *(u32x2*)(MK + (size_t)row * 1024 + col) = w; }
                        else *(f32x4*)(outV + (size_t)row * 1024 + col - 1024) = v;
                    }
            }
    }
};

struct EpiMerge {
    static constexpr bool PERM = true, AFTER_DRAIN = false;
    const bf16_t* gate; bf16_t* MRG; int first;
    DI void operator()(const AccT& acc, const Unit& u, int wr, int wc, int fr, int fq) const {
#pragma unroll
        for (int ai = 0; ai < 2; ++ai) {
            u32x4 gw[4][2], pw[4][2];
#pragma unroll
            for (int m = 0; m < 4; ++m)
#pragma unroll
                for (int bj = 0; bj < 2; ++bj) {
                    const int row = u.pm * 256 + ai * 128 + wr * 64 + m * 16 + fr, col0 = u.pn * 256 + bj * 128 + wc * 32 + fq * 8;
                    gw[m][bj] = *(const u32x4*)(gate + (size_t)row * NZ + col0);
                    pw[m][bj] = first ? (u32x4){0u, 0u, 0u, 0u} : *(const u32x4*)(MRG + (size_t)row * 1024 + col0);
                }
#pragma unroll
            for (int m = 0; m < 4; ++m)
#pragma unroll
                for (int bj = 0; bj < 2; ++bj) {
                    const int row = u.pm * 256 + ai * 128 + wr * 64 + m * 16 + fr, col0 = u.pn * 256 + bj * 128 + wc * 32 + fq * 8;
                    const u32x4 g4 = gw[m][bj], p4 = pw[m][bj];
                    f32x4 a = acc[ai][bj][m][0], b = acc[ai][bj][m][1];
                    a[0] = a[0] * bflo(g4.x) + bflo(p4.x); a[1] = a[1] * bfhi(g4.x) + bfhi(p4.x); a[2] = a[2] * bflo(g4.y) + bflo(p4.y); a[3] = a[3] * bfhi(g4.y) + bfhi(p4.y);
                    b[0] = b[0] * bflo(g4.z) + bflo(p4.z); b[1] = b[1] * bfhi(g4.z) + bfhi(p4.z); b[2] = b[2] * bflo(g4.w) + bflo(p4.w); b[3] = b[3] * bfhi(g4.w) + bfhi(p4.w);
                    st8(MRG + (size_t)row * 1024 + col0, a, b);
                }
        }
    }
};

struct EpiOut {
    static constexpr bool PERM = false, AFTER_DRAIN = false;
    const float* X; bf16_t* HB; float* sh;
    DI void operator()(const AccT& acc, const Unit& u, int wr, int wc, int fr, int fq) const {
#pragma unroll
        for (int ai = 0; ai < 2; ++ai)
#pragma unroll
            for (int mp = 0; mp < 2; ++mp) {
                f32x4 xv[2][2][2];
#pragma unroll
                for (int mm = 0; mm < 2; ++mm)
#pragma unroll
                    for (int bj = 0; bj < 2; ++bj)
#pragma unroll
                        for (int n = 0; n < 2; ++n) {
                            const int row = u.pm * 256 + ai * 128 + wr * 64 + (2 * mp + mm) * 16 + fr;
                            xv[mm][bj][n] = *(const f32x4*)(X + (size_t)row * 1024 + u.pn * 256 + bj * 128 + wc * 32 + n * 16 + fq * 4);
                        }
#pragma unroll
                for (int mm = 0; mm < 2; ++mm) {
                    const int m = 2 * mp + mm, row = u.pm * 256 + ai * 128 + wr * 64 + m * 16 + fr; float ss = 0.f;
#pragma unroll
                    for (int bj = 0; bj < 2; ++bj)
#pragma unroll
                        for (int n = 0; n < 2; ++n) {
                            const size_t o = (size_t)row * 1024 + u.pn * 256 + bj * 128 + wc * 32 + n * 16 + fq * 4;
                            const f32x4 v = xv[mm][bj][n] + acc[ai][bj][m][n];
                            u32x2 w; w.x = pk2(v[0], v[1]); w.y = pk2(v[2], v[3]); *(u32x2*)(HB + o) = w;
                            ss += (v[0] * v[0] + v[1] * v[1]) + (v[2] * v[2] + v[3] * v[3]);
                        }
                    ss += __shfl_xor(ss, 16); ss += __shfl_xor(ss, 32); if (fq == 0) atomicAdd(sh + row, ss);
                }
            }
    }
};

struct EpiFfnUp {
    static constexpr bool PERM = true, AFTER_DRAIN = false;
    bf16_t* ACT; const float* sh;
    DI void operator()(const AccT& acc, const Unit& u, int wr, int wc, int fr, int fq) const {
        float sv_[2][4];
#pragma unroll
        for (int ai = 0; ai < 2; ++ai)
#pragma unroll
            for (int m = 0; m < 4; ++m) sv_[ai][m] = sh[u.pm * 256 + ai * 128 + wr * 64 + m * 16 + fr];
#pragma unroll
        for (int ai = 0; ai < 2; ++ai)
#pragma unroll
            for (int m = 0; m < 4; ++m) {
                const int row = u.pm * 256 + ai * 128 + wr * 64 + m * 16 + fr;
                const float rs = rsqrtf(sv_[ai][m] * (1.0f / 1024.0f) + EPS);
#pragma unroll
                for (int bj = 0; bj < 2; ++bj) {
                    const int col0 = u.pn * 256 + bj * 128 + wc * 32 + fq * 8;
                    const f32x4 g = acc[ai][bj][m][0] * rs, uu = acc[ai][bj][m][1] * rs; f32x4 r;
#pragma unroll
                    for (int j = 0; j < 4; ++j) r[j] = g[j] * sigm(g[j]) * uu[j];
                    u32x2 w; w.x = pk2(r[0], r[1]); w.y = pk2(r[2], r[3]); *(u32x2*)(ACT + (size_t)row * DFF + (col0 >> 1)) = w;
                }
            }
    }
};

struct EpiDown {
    static constexpr bool PERM = false, AFTER_DRAIN = false;
    float* H; float* sh2; const bf16_t* HBsrc;
    DI void operator()(const AccT& acc, const Unit& u, int wr, int wc, int fr, int fq) const {
#pragma unroll
        for (int ai = 0; ai < 2; ++ai)
#pragma unroll
            for (int m = 0; m < 4; ++m) {
                const int row = u.pm * 256 + ai * 128 + wr * 64 + m * 16 + fr; float ss = 0.f;
#pragma unroll
                for (int bj = 0; bj < 2; ++bj)
#pragma unroll
                    for (int n = 0; n < 2; ++n) {
                        const size_t o = (size_t)row * 1024 + u.pn * 256 + bj * 128 + wc * 32 + n * 16 + fq * 4;
                        f32x4 hv; if (HBsrc) { const u32x2 hw = *(const u32x2*)(HBsrc + o); hv = (f32x4){bflo(hw.x), bfhi(hw.x), bflo(hw.y), bfhi(hw.y)}; } else hv = *(const f32x4*)(H + o);
                        const f32x4 v = hv + acc[ai][bj][m][n];
                        *(f32x4*)(H + o) = v; ss += (v[0] * v[0] + v[1] * v[1]) + (v[2] * v[2] + v[3] * v[3]);
                    }
                if (sh2) { ss += __shfl_xor(ss, 16); ss += __shfl_xor(ss, 32); if (fq == 0) atomicAdd(sh2 + row, ss); }
            }
    }
};


struct EpiDownNorm {
    static constexpr bool PERM = false, AFTER_DRAIN = true;
    float* Y; float* sh2; const bf16_t* HB; const float* gfin; unsigned* cnt;
    DI void fused(AccT& acc, const Unit& u, int wr, int wc, int fr, int fq, int wid, int lane) const {
#pragma unroll
        for (int ai = 0; ai < 2; ++ai) {
            u32x2 hb[4][2][2];
#pragma unroll
            for (int m = 0; m < 4; ++m)
#pragma unroll
                for (int bj = 0; bj < 2; ++bj)
#pragma unroll
                    for (int n = 0; n < 2; ++n) hb[m][bj][n] = *(const u32x2*)(HB + (size_t)(u.pm * 256 + ai * 128 + wr * 64 + m * 16 + fr) * 1024 + u.pn * 256 + bj * 128 + wc * 32 + n * 16 + fq * 4);
#pragma unroll
            for (int m = 0; m < 4; ++m) {
                const int row = u.pm * 256 + ai * 128 + wr * 64 + m * 16 + fr; float ss = 0.f;
#pragma unroll
                for (int bj = 0; bj < 2; ++bj)
#pragma unroll
                    for (int n = 0; n < 2; ++n) {
                        const u32x2 hw = hb[m][bj][n];
                        const f32x4 v = (f32x4){bflo(hw.x), bfhi(hw.x), bflo(hw.y), bfhi(hw.y)} + acc[ai][bj][m][n];
                        acc[ai][bj][m][n] = v; ss += (v[0] * v[0] + v[1] * v[1]) + (v[2] * v[2] + v[3] * v[3]);
                    }
                ss += __shfl_xor(ss, 16); ss += __shfl_xor(ss, 32); if (fq == 0) atomicAdd(sh2 + row, ss);
            }
        }
        asm volatile("s_waitcnt vmcnt(0)" ::: "memory");
        unsigned* c = cnt + 64 * u.pm;
        if (lane == 0) __hip_atomic_fetch_add(c, 1u, __ATOMIC_RELAXED, __HIP_MEMORY_SCOPE_AGENT);
        if (wid == 0) { unsigned sp = 0;
            while ((unsigned)__builtin_amdgcn_readfirstlane(__hip_atomic_load(c, __ATOMIC_RELAXED, __HIP_MEMORY_SCOPE_AGENT)) < 32u) { __builtin_amdgcn_s_sleep(2); if (++sp > (1u << 21)) break; } }
        __syncthreads();
        float sv_[2][4]; f32x4 gf[2][2];
#pragma unroll
        for (int ai = 0; ai < 2; ++ai)
#pragma unroll
            for (int m = 0; m < 4; ++m) sv_[ai][m] = __hip_atomic_load(sh2 + u.pm * 256 + ai * 128 + wr * 64 + m * 16 + fr, __ATOMIC_RELAXED, __HIP_MEMORY_SCOPE_AGENT);
#pragma unroll
        for (int bj = 0; bj < 2; ++bj)
#pragma unroll
            for (int n = 0; n < 2; ++n) gf[bj][n] = *(const f32x4*)(gfin + u.pn * 256 + bj * 128 + wc * 32 + n * 16 + fq * 4);
#pragma unroll
        for (int ai = 0; ai < 2; ++ai)
#pragma unroll
            for (int m = 0; m < 4; ++m) {
                const int row = u.pm * 256 + ai * 128 + wr * 64 + m * 16 + fr;
                const float rs = rsqrtf(sv_[ai][m] * (1.0f / 1024.0f) + EPS);
#pragma unroll
                for (int bj = 0; bj < 2; ++bj)
#pragma unroll
                    for (int n = 0; n < 2; ++n) {
                        const int col = u.pn * 256 + bj * 128 + wc * 32 + n * 16 + fq * 4;
                        *(f32x4*)(Y + (size_t)row * 1024 + col) = acc[ai][bj][m][n] * rs * gf[bj][n];
                    }
            }
    }
};

template <class Map>
DI void tr_weight(const float* W, int ldw, int K, int nrows, bf16_t* WT, const float* gk, Map map, LAS float* scr, int gw, int ngw, int lane) {
    const int nrb = nrows / 32, items = (K / 64) * nrb;
    for (int it = gw; it < items; it += ngw) {
        const int kb = it / nrb, rb = it % nrb, k0 = kb * 64, r0 = rb * 32;
        const int c = map(r0 + (lane & 31));
#pragma unroll 8
        for (int i = 0; i < 32; ++i) { const int kk = 2 * i + (lane >> 5); float v = c >= 0 ? W[(size_t)(k0 + kk) * ldw + c] : 0.f; if (gk) v *= gk[k0 + kk]; scr[kk * 33 + (lane & 31)] = v; }
        asm volatile("s_waitcnt lgkmcnt(0)" ::: "memory");
        const int cc = lane & 7;
#pragma unroll
        for (int j = 0; j < 4; ++j) { const int n = (lane >> 3) + 8 * j; const LAS float* s = scr + (8 * cc) * 33 + n;
            u32x4 o; o.x = pk2(s[0], s[33]); o.y = pk2(s[66], s[99]); o.z = pk2(s[132], s[165]); o.w = pk2(s[198], s[231]);
            *(u32x4*)(WT + (size_t)(r0 + n) * K + k0 + 8 * cc) = o; }
        asm volatile("s_waitcnt lgkmcnt(0)" ::: "memory");
    }
}
struct MapId { int off; DI int operator()(int r) const { return r + off; } };
struct MapIn { DI int operator()(int r) const {
    if (r < 2432) return r;
    if (r < 2496) { const int x = r - 2432; return 2688 + (x & 1) * 32 + (x >> 1); }
    if (r < 2560) return -1;
    if (r < 2816) return 2432 + (r - 2560);
    return r - 64; } };
struct MapUq { DI int operator()(int r) const { const int h = r / 192, d = r % 192; if (d < 128) return r; const int x = d - 128; return h * 192 + 128 + (x & 1) * 32 + (x >> 1); } };
struct MapGU { const float* dummy; DI int operator()(int r) const { return 0; } };

DI void rms_row_bf16(const float* xr, const float* g, bf16_t* orow, int lane) {
    f32x4 v[4]; float s = 0.f;
#pragma unroll
    for (int j = 0; j < 4; ++j) { v[j] = ((const f32x4*)xr)[lane + 64 * j]; s += (v[j][0] * v[j][0] + v[j][1] * v[j][1]) + (v[j][2] * v[j][2] + v[j][3] * v[j][3]); }
    const float rs = rsqrtf(wave_sum(s) * (1.0f / 1024.0f) + EPS);
#pragma unroll
    for (int j = 0; j < 4; ++j) { const f32x4 gg = ((const f32x4*)g)[lane + 64 * j]; u32x2 w; w.x = pk2(v[j][0] * rs * gg[0], v[j][1] * rs * gg[1]); w.y = pk2(v[j][2] * rs * gg[2], v[j][3] * rs * gg[3]);
        ((u32x2*)orow)[lane + 64 * j] = w; }
}

DI void rms_row2_bf16(const float* xa, const float* xb, bool hasb, const float* g, bf16_t* oa, bf16_t* ob, int lane) {
    f32x4 va[4], vb[4]; float sa = 0.f, sb = 0.f;
#pragma unroll
    for (int j = 0; j < 4; ++j) { va[j] = ((const f32x4*)xa)[lane + 64 * j]; vb[j] = hasb ? ((const f32x4*)xb)[lane + 64 * j] : (f32x4){0.f, 0.f, 0.f, 0.f}; }
    f32x4 gg[4];
#pragma unroll
    for (int j = 0; j < 4; ++j) gg[j] = ((const f32x4*)g)[lane + 64 * j];
#pragma unroll
    for (int j = 0; j < 4; ++j) { sa += (va[j][0] * va[j][0] + va[j][1] * va[j][1]) + (va[j][2] * va[j][2] + va[j][3] * va[j][3]); sb += (vb[j][0] * vb[j][0] + vb[j][1] * vb[j][1]) + (vb[j][2] * vb[j][2] + vb[j][3] * vb[j][3]); }
    const float ra = rsqrtf(wave_sum(sa) * (1.0f / 1024.0f) + EPS), rb = rsqrtf(wave_sum(sb) * (1.0f / 1024.0f) + EPS);
#pragma unroll
    for (int j = 0; j < 4; ++j) { u32x2 w; w.x = pk2(va[j][0] * ra * gg[j][0], va[j][1] * ra * gg[j][1]); w.y = pk2(va[j][2] * ra * gg[j][2], va[j][3] * ra * gg[j][3]); ((u32x2*)oa)[lane + 64 * j] = w; }
    if (hasb) {
#pragma unroll
        for (int j = 0; j < 4; ++j) { u32x2 w; w.x = pk2(vb[j][0] * rb * gg[j][0], vb[j][1] * rb * gg[j][1]); w.y = pk2(vb[j][2] * rb * gg[j][2], vb[j][3] * rb * gg[j][3]); ((u32x2*)ob)[lane + 64 * j] = w; } }
}

template <int DQK, bool MLA, bool QREG = true>
DI void attn_unit(LAS unsigned char* lds, const bf16_t* Q, int ldq, int nqv, const bf16_t* K1, int ldk1, const bf16_t* K2, const bf16_t* VT, int ldv,
                  int ntiles, int lim, int nkeys, bf16_t* O, int ldo, int tid, int wid, int lane) {
    constexpr int KS = DQK + 8, KBYTES = 64 * KS * 2, VBYTES = 128 * 136, BUF = KBYTES + VBYTES, KP = DQK / 64;
    const int r = lane & 31, h = lane >> 5;
    bf16x8 qf[QREG ? DQK / 16 : 1];
    const bf16x8 zero8 = {0, 0, 0, 0, 0, 0, 0, 0};
    const bool qok = (wid * 32 + r) < nqv; const bf16_t* qptr = Q + (size_t)(wid * 32 + r) * ldq + 8 * h;
    if (QREG) {
#pragma unroll
      for (int s = 0; s < DQK / 16; ++s) qf[QREG ? s : 0] = qok ? *(const bf16x8*)(qptr + 16 * s) : zero8; }
#define ATT_Q(s) (QREG ? qf[QREG ? (s) : 0] : (qok ? *(const bf16x8*)(qptr + 16 * (s)) : zero8))
    f32x16 o[4];
#pragma unroll
    for (int i = 0; i < 4; ++i)
#pragma unroll
        for (int j = 0; j < 16; ++j) o[i][j] = 0.f;
    float mrun = -1e30f, lrun = 0.f;
    u32x4 kreg[KP]; u32x2 vreg[4];
    const unsigned kgo1 = (unsigned)((tid >> 3) * ldk1 + (tid & 7) * 8) * 2u;
    const unsigned vgo = (unsigned)((tid >> 3) * ldv + (tid & 7) * 8) * 2u, vgs = (unsigned)ldv * 128u;
    const unsigned klo = (unsigned)((tid >> 3) * (KS * 2) + (tid & 7) * 16), vlo = (unsigned)(KBYTES + (tid >> 3) * 136 + (tid & 7) * 16);
#define ATT_LOADK(t) do { const char* k1_ = (const char*)K1 + (size_t)(t) * 128 * ldk1; const char* k2_ = (const char*)K2 + (size_t)(t) * 8192; \
    _Pragma("unroll") for (int j = 0; j < KP; ++j) { \
        if (MLA && j == 2) kreg[j] = *(const u32x4*)(k2_ + ((unsigned)tid << 4)); else kreg[j] = *(const u32x4*)(k1_ + kgo1 + j * 128); } } while (0)
#define ATT_LOADV(t) do { const char* v_ = (const char*)VT + (size_t)(t) * 128; \
    _Pragma("unroll") for (int j = 0; j < 2; ++j) { const u32x4 w = *(const u32x4*)(v_ + vgo + j * vgs); \
        vreg[2 * j] = (u32x2){w.x, w.y}; vreg[2 * j + 1] = (u32x2){w.z, w.w}; } } while (0)
#define ATT_STOREK(buf) do { LAS unsigned char* kb_ = lds + (buf) * BUF + klo; \
    _Pragma("unroll") for (int j = 0; j < KP; ++j) *(LAS u32x4*)(kb_ + j * 128) = kreg[j]; } while (0)
#define ATT_STOREV(buf) do { LAS unsigned char* vb_ = lds + (buf) * BUF + vlo; \
    _Pragma("unroll") for (int j = 0; j < 2; ++j) { *(LAS u32x2*)(vb_ + j * 64 * 136) = vreg[2 * j]; *(LAS u32x2*)(vb_ + j * 64 * 136 + 8) = vreg[2 * j + 1]; } } while (0)
#define ATT_QK() \
    _Pragma("unroll") for (int j = 0; j < 16; ++j) { s0_[j] = 0.f; s1_[j] = 0.f; } \
    _Pragma("unroll") for (int s = 0; s < DQK / 16; ++s) { \
        const bf16x8 a0_ = *(const LAS bf16x8*)(kb + r * (KS * 2) + (16 * s + 8 * h) * 2); \
        const bf16x8 a1_ = *(const LAS bf16x8*)(kb + (r + 32) * (KS * 2) + (16 * s + 8 * h) * 2); \
        const bf16x8 q_ = ATT_Q(s); \
        s0_ = __builtin_amdgcn_mfma_f32_32x32x16_bf16(a0_, q_, s0_, 0, 0, 0); \
        s1_ = __builtin_amdgcn_mfma_f32_32x32x16_bf16(a1_, q_, s1_, 0, 0, 0); }
#define ATT_SMPV() do { \
    if (64 * t + 64 > nkeys) { \
        _Pragma("unroll") for (int i = 0; i < 16; ++i) { const int key = 64 * t + 8 * (i >> 2) + 4 * h + (i & 3); if (key >= nkeys) s0_[i] = -1e30f; if (key + 32 >= nkeys) s1_[i] = -1e30f; } } \
    float mx = fmaxf(max16(s0_), max16(s1_)); \
    mx = fmaxf(mx, __shfl_xor(mx, 32)); \
    if (__builtin_amdgcn_ballot_w64(mx > mrun + 8.0f)) { \
        const float mnew = (mx > mrun + 8.0f) ? mx : mrun, alpha = ex2(mrun - mnew); mrun = mnew; lrun *= alpha; \
        _Pragma("unroll") for (int i = 0; i < 4; ++i) _Pragma("unroll") for (int j = 0; j < 16; ++j) o[i][j] *= alpha; } \
    float ps = 0.f; \
    _Pragma("unroll") for (int i = 0; i < 16; ++i) { s0_[i] = ex2(s0_[i] - mrun); s1_[i] = ex2(s1_[i] - mrun); ps += s0_[i] + s1_[i]; } \
    lrun += ps; \
    bf16x8 pf_[4]; \
    _Pragma("unroll") for (int q = 0; q < 2; ++q) { \
        u32x4 w0, w1; \
        w0.x = pk2(s0_[8 * q + 0], s0_[8 * q + 1]); w0.y = pk2(s0_[8 * q + 2], s0_[8 * q + 3]); w0.z = pk2(s0_[8 * q + 4], s0_[8 * q + 5]); w0.w = pk2(s0_[8 * q + 6], s0_[8 * q + 7]); \
        w1.x = pk2(s1_[8 * q + 0], s1_[8 * q + 1]); w1.y = pk2(s1_[8 * q + 2], s1_[8 * q + 3]); w1.z = pk2(s1_[8 * q + 4], s1_[8 * q + 5]); w1.w = pk2(s1_[8 * q + 6], s1_[8 * q + 7]); \
        pf_[q] = __builtin_bit_cast(bf16x8, w0); pf_[2 + q] = __builtin_bit_cast(bf16x8, w1); } \
    _Pragma("unroll") for (int ks = 0; ks < 4; ++ks) _Pragma("unroll") for (int v4 = 0; v4 < 4; ++v4) { \
        const LAS unsigned char* vp = vb + (32 * v4 + r) * 136 + (16 * ks + 4 * h) * 2; \
        const u32x2 lo = *(const LAS u32x2*)vp, hi = *(const LAS u32x2*)(vp + 16); \
        const u32x4 aw = {lo.x, lo.y, hi.x, hi.y}; \
        o[v4] = __builtin_amdgcn_mfma_f32_32x32x16_bf16(__builtin_bit_cast(bf16x8, aw), pf_[ks], o[v4], 0, 0, 0); } } while (0)
    ATT_LOADK(0); ATT_LOADV(0); ATT_STOREK(0); ATT_STOREV(0);
    __syncthreads();
    for (int t = 0; t < ntiles; ++t) {
        const int buf = t & 1; const bool more = t + 1 < ntiles;
        const LAS unsigned char* kb = lds + buf * BUF; const LAS unsigned char* vb = kb + KBYTES;
        f32x16 s0_, s1_;
        if (more) ATT_LOADK(t + 1);
        if (t < lim) { ATT_QK() }
        if (more) { ATT_STOREK(buf ^ 1); ATT_LOADV(t + 1); }
        if (t < lim) ATT_SMPV();
        if (more) ATT_STOREV(buf ^ 1);
        __syncthreads();
    }
#undef ATT_QK
#undef ATT_Q
#undef ATT_SMPV
#undef ATT_LOADK
#undef ATT_LOADV
#undef ATT_STOREK
#undef ATT_STOREV
    lrun += __shfl_xor(lrun, 32);
    const float il = rcpf(lrun);
    const int t3 = lane_id();
    const int qrow = wid * 32 + (t3 & 31), h3 = t3 >> 5;
    if (lim > 0 && qrow < nqv) {
        bf16_t* op = O + (size_t)qrow * ldo + 4 * h3;
#pragma unroll
        for (int v4 = 0; v4 < 4; ++v4)
#pragma unroll
            for (int g4 = 0; g4 < 4; ++g4) {
                u32x2 w; w.x = pk2(o[v4][4 * g4] * il, o[v4][4 * g4 + 1] * il); w.y = pk2(o[v4][4 * g4 + 2] * il, o[v4][4 * g4 + 3] * il);
                *(u32x2*)(op + 32 * v4 + 8 * g4) = w;
            }
    }
}

DI void gm_unit(LAS unsigned char* lds, const bf16_t* Zrow0  , int nvalid, int gch, const bf16_t* Wsb, const float* bs, const float* gmg, const float* sv,
                bf16_t* OG  , int tid, int wid, int lane) {
    LAS unsigned char* Wl = lds; LAS unsigned char* Vt = lds + 128 * 272;
#pragma unroll
    for (int j = 0; j < 4; ++j) { const int p = tid + 512 * j, pr = p >> 4, c8 = p & 15; *(LAS u32x4*)(Wl + pr * 272 + c8 * 16) = *(const u32x4*)(Wsb + (size_t)gch * 16384 + pr * 128 + c8 * 8); }
#pragma unroll
    for (int j = 0; j < 4; ++j) {
        const int p = tid + 512 * j, q = p & 127, cg = p >> 7;
        u32x4 w = {0u, 0u, 0u, 0u}; float rs = 0.f;
        if (q < nvalid) { w = *(const u32x4*)(Zrow0 + (size_t)q * NZ + ZV + gch * 128 + cg * 8); rs = rsqrtf(sv[q] * (1.0f / 1024.0f) + EPS); }
        const f32x4 g0 = *(const f32x4*)(gmg + gch * 128 + cg * 8), g1 = *(const f32x4*)(gmg + gch * 128 + cg * 8 + 4);
        float e[8] = {bflo(w.x) * g0[0], bfhi(w.x) * g0[1], bflo(w.y) * g0[2], bfhi(w.y) * g0[3], bflo(w.z) * g1[0], bfhi(w.z) * g1[1], bflo(w.w) * g1[2], bfhi(w.w) * g1[3]};
#pragma unroll
        for (int k = 0; k < 8; ++k) { const unsigned pw = pk2(e[k] * rs, 0.f); *(LAS unsigned short*)(Vt + (cg * 8 + k) * 272 + q * 2) = (unsigned short)(pw & 0xffffu); }
    }
    __syncthreads();
    const int r = lane & 31, h = lane >> 5, cb = wid >> 1;
#pragma unroll
    for (int pi = 0; pi < 2; ++pi) {
        const int pb = 2 * (wid & 1) + pi;
        f32x16 acc;
#pragma unroll
        for (int j = 0; j < 16; ++j) acc[j] = 0.f;
        for (int ks = 0; ks < 2 * pb + 2; ++ks) {
            const bf16x8 a = *(const LAS bf16x8*)(Vt + (32 * cb + r) * 272 + (16 * ks + 8 * h) * 2);
            const bf16x8 b = *(const LAS bf16x8*)(Wl + (32 * pb + r) * 272 + (16 * ks + 8 * h) * 2);
            acc = __builtin_amdgcn_mfma_f32_32x32x16_bf16(a, b, acc, 0, 0, 0);
        }
        const int p = 32 * pb + r;
        if (p < nvalid) {
            const float bias = bs[gch * 128 + p];
            u32x2 uws[4];
#pragma unroll
            for (int g4 = 0; g4 < 4; ++g4) uws[g4] = *(const u32x2*)(Zrow0 + (size_t)p * NZ + ZU + gch * 128 + 32 * cb + 8 * g4 + 4 * h);
#pragma unroll
            for (int g4 = 0; g4 < 4; ++g4) {
                const int c = gch * 128 + 32 * cb + 8 * g4 + 4 * h;
                const u32x2 uw = uws[g4];
                u32x2 w; w.x = pk2(bflo(uw.x) * (acc[4 * g4] + bias), bfhi(uw.x) * (acc[4 * g4 + 1] + bias)); w.y = pk2(bflo(uw.y) * (acc[4 * g4 + 2] + bias), bfhi(uw.y) * (acc[4 * g4 + 3] + bias));
                *(u32x2*)(OG + (size_t)p * 1024 + c) = w;
            }
        }
    }
    __syncthreads();
}


#define XB_TMO      128
#define XB_XCNT(j)  (256  + 64 * (j))
#define XB_XSUB(j)  (1280 + 64 * (j))
#define XB_XGEN(j)  (2304 + 64 * (j))
#define XB_TOP      3328
#define XB_TOPGEN   3392
#define XCD_BAR_WORDS 3456
#define XB_SPIN_CAP (1u << 22)
DI unsigned xb_ld(unsigned* p)              { return __hip_atomic_load(p, __ATOMIC_RELAXED, __HIP_MEMORY_SCOPE_AGENT); }
DI unsigned xb_add(unsigned* p, unsigned v) { return __hip_atomic_fetch_add(p, v, __ATOMIC_RELAXED, __HIP_MEMORY_SCOPE_AGENT); }
DI unsigned xb_xcc_id() { return (unsigned)__builtin_amdgcn_s_getreg((3 << 11) | 20) & 0xFu; }
#define XB_SPIN(cond, bar) do { unsigned _sp = 0; while (cond) { __builtin_amdgcn_s_sleep(1); \
    if ((++_sp & 255u) == 0u) { if (xb_ld(&(bar)[XB_TMO])) break; if (_sp > XB_SPIN_CAP) { atomicAdd(&(bar)[XB_TMO], 1u); break; } } } } while (0)
DI void xcd_barrier_complete(unsigned* bar, unsigned x, unsigned& nloc, unsigned& nx) {
    const unsigned Gn = gridDim.x * gridDim.y * gridDim.z;
    unsigned sum, cnt, mine, sp = 0u;
    for (;;) {
        sum = 0u; cnt = 0u; mine = 0u;
#pragma unroll
        for (unsigned j = 0; j < 16; ++j) { const unsigned c = xb_ld(&bar[XB_XCNT(j)]); sum += c; cnt += (c > 0u) ? 1u : 0u; mine = (j == x) ? c : mine; }
        if (sum == Gn) break;
        __builtin_amdgcn_s_sleep(1);
        if ((++sp & 255u) == 0u) { if (xb_ld(&bar[XB_TMO])) break; if (sp > XB_SPIN_CAP) { atomicAdd(&bar[XB_TMO], 1u); break; } }
    }
    nloc = mine > 0u ? mine : 1u; nx = cnt > 0u ? cnt : 1u;
}
DI void xcd_barrier(unsigned* bar, volatile LAS unsigned* st) {
    asm volatile("s_waitcnt vmcnt(0)" ::: "memory");
    __syncthreads();
    if (threadIdx.x == 0) {
        __builtin_amdgcn_s_waitcnt(0);
        const unsigned x = xb_xcc_id();
        unsigned nloc = st[0], nx = st[1];
        if (nloc == 0u) { xcd_barrier_complete(bar, x, nloc, nx); st[0] = nloc; st[1] = nx; }
        const unsigned old = xb_add(&bar[XB_XSUB(x)], 1u);
        const unsigned gen = old / nloc;
        if (old + 1u == (gen + 1u) * nloc) {
            __builtin_amdgcn_fence(__ATOMIC_RELEASE, "agent");
            asm volatile("s_waitcnt vmcnt(0)" ::: "memory");
            const unsigned og = xb_add(&bar[XB_TOP], 1u);
            const unsigned tg = og / nx;
            if (og + 1u == (tg + 1u) * nx) xb_add(&bar[XB_TOPGEN], 1u);
            else XB_SPIN(xb_ld(&bar[XB_TOPGEN]) == tg, bar);
            __builtin_amdgcn_fence(__ATOMIC_ACQUIRE, "agent");
            xb_add(&bar[XB_XGEN(x)], 1u);
            asm volatile("s_waitcnt vmcnt(0)" ::: "memory");
        } else {
            XB_SPIN(xb_ld(&bar[XB_XGEN(x)]) == gen, bar);
            __builtin_amdgcn_fence(__ATOMIC_ACQUIRE, "agent");
            asm volatile("s_waitcnt vmcnt(0)" ::: "memory");
        }
    }
    __syncthreads();
}

struct Params { const float* in[28]; float* out; unsigned char* ws; };
typedef const Params __attribute__((address_space(4))) CParams;

__global__ void __launch_bounds__(512, 2) fwd_mega(Params P) {
    extern __shared__ __attribute__((aligned(16))) unsigned char lds_raw[];
    LAS unsigned char* lds = (LAS unsigned char*)lds_raw;
    const int G = (int)gridDim.x, bid = (int)blockIdx.x, ngw = G * 8, wid0 = __builtin_amdgcn_readfirstlane((int)threadIdx.x >> 6);
#define run_gemm(...) run_gemm_(__VA_ARGS__, wid0)
    const size_t ngt = (size_t)G * 512;
    CParams* pp; unsigned char* ws; float* out; int tid, lane, wid, gw; size_t gt;
#define PHASE_BEGIN do { pp = (CParams*)__builtin_amdgcn_kernarg_segment_ptr(); asm volatile("" : "+s"(pp)); ws = pp->ws; out = pp->out; \
    lane = lane_id(); wid = wid0; tid = wid0 * 64 + lane; gw = bid * 8 + wid; gt = (size_t)bid * 512 + tid; } while (0)
#define WSB(off) ((bf16_t*)(ws + (off)))
#define ST ((float*)(ws + WS_STAT))
#define st_v ST
#define st_q (ST + NSTAT)
#define st_kv (ST + 2 * NSTAT)
#define st_h (ST + 3 * NSTAT)
#define st_h2 (ST + 4 * NSTAT)

    volatile LAS unsigned* bst = (volatile LAS unsigned*)(lds + 131072);
    if (threadIdx.x < 4) bst[threadIdx.x] = 0u;
    __syncthreads();
    if (threadIdx.x == 0) (void)xb_add(&((unsigned*)(P.ws + WS_BAR))[XB_XCNT(xb_xcc_id())], 1u);
#define GRID_BAR() xcd_barrier((unsigned*)(ws + WS_BAR), bst)
    PHASE_BEGIN;
    {
        LAS float* scr = (LAS float*)(lds + wid * 8704);
        {
            constexpr int I_IN = 16 * 216, I_UQ = 6 * 48, I_KV4 = 4 * 128, I_WKV = 16 * 64, I_BR4 = 4 * 512, I_DN = 44 * 32, I_GU = 16 * 176, I_MV = 32 * 128;
            constexpr int TOT = I_IN + I_UQ + I_KV4 + I_WKV + I_BR4 + I_DN + I_GU + I_MV;
            for (int it0 = gw; it0 < TOT; it0 += ngw) {
                int it = it0; const float* W; const float* gk = nullptr; bf16_t* WT; int ldw, K, nrb, mapid = 0;
                if (it < I_IN) { W = pp->in[8]; ldw = 6848; K = 1024; nrb = 216; WT = WSB(WS_WIN); mapid = 1; }
                else if ((it -= I_IN) < I_UQ) { W = pp->in[13]; ldw = 1536; K = 384; nrb = 48; WT = WSB(WS_WUQ); gk = pp->in[12]; mapid = 2; }
                else if ((it -= I_UQ) < I_KV4) { const int w = it >> 7; it &= 127; W = pp->in[w < 2 ? 15 : 16]; ldw = 1024; K = 256; nrb = 32; WT = WSB(WS_WUKF) + (size_t)w * 262144; gk = (w & 1) ? nullptr : pp->in[14]; }
                else if ((it -= I_KV4) < I_WKV) { W = pp->in[18]; ldw = 2048; K = 1024; nrb = 64; WT = WSB(WS_WKV); }
                else if ((it -= I_WKV) < I_BR4) { const int w = it >> 9; it &= 511; W = pp->in[19 + w]; ldw = 1024; K = 1024; nrb = 32; WT = WSB(WS_WBG) + (size_t)w * 1048576; }
                else if ((it -= I_BR4) < I_DN) { W = pp->in[26]; ldw = 1024; K = DFF; nrb = 32; WT = WSB(WS_WDN); }
                else if ((it -= I_DN) < I_GU) { W = pp->in[24]; ldw = DFF; K = 1024; nrb = 176; WT = WSB(WS_WGU); gk = pp->in[23]; mapid = 3; }
                else { it -= I_GU; const int b = it >> 7; it &= 127; W = pp->in[5] + (size_t)b * 262144; ldw = 1024; K = 256; nrb = 32; WT = WSB(WS_MVTS) + (size_t)b * 262144; }
                const int kb = it / nrb, rb = it % nrb, k0 = kb * 64, r0 = rb * 32, dr = r0 + (lane & 31);
                int c = dr;
                if (mapid == 1) c = MapIn{}(dr); else if (mapid == 2) c = MapUq{}(dr);
                else if (mapid == 3) { const int e = dr & 7; c = 4 * (dr >> 3) + (e & 3); if (e >= 4) W = pp->in[25]; }
#pragma unroll 16
                for (int i = 0; i < 32; ++i) { const int kk = 2 * i + (lane >> 5); float v = c >= 0 ? W[(size_t)(k0 + kk) * ldw + c] : 0.f; if (gk) v *= gk[k0 + kk]; scr[kk * 33 + (lane & 31)] = v; }
                asm volatile("s_waitcnt lgkmcnt(0)" ::: "memory");
                const int cc = lane & 7;
#pragma unroll
                for (int j = 0; j < 4; ++j) { const int n = (lane >> 3) + 8 * j; const LAS float* s = scr + (8 * cc) * 33 + n;
                    u32x4 o; o.x = pk2(s[0], s[33]); o.y = pk2(s[66], s[99]); o.z = pk2(s[132], s[165]); o.w = pk2(s[198], s[231]);
                    *(u32x4*)(WT + (size_t)(r0 + n) * K + k0 + 8 * cc) = o; }
                asm volatile("s_waitcnt lgkmcnt(0)" ::: "memory");
            }
        }
        for (size_t i = gt; i < 131072; i += ngt) { const int p = (int)((i >> 7) & 127), q = (int)(i & 127); WSB(WS_WS)[i] = (bf16_t)(pk2(q <= p ? pp->in[10][i] : 0.f, 0.f) & 0xffffu); }
        for (size_t i = gt; i < (size_t)5 * NSTAT; i += ngt) ST[i] = 0.f;
        for (int m = gw; m < MG; m += 2 * ngw) rms_row2_bf16(pp->in[0] + (size_t)m * 1024, pp->in[0] + (size_t)(m + ngw) * 1024, m + ngw < MG, pp->in[7], WSB(WS_XN) + (size_t)m * 1024, WSB(WS_XN) + (size_t)(m + ngw) * 1024, lane);
        for (int m = gw; m < MS; m += ngw) rms_row_bf16(pp->in[1] + (size_t)m * 1024, pp->in[7], WSB(WS_XNS) + (size_t)m * 1024, lane);
        for (int m = gw; m < 8192; m += 2 * ngw) rms_row2_bf16(pp->in[6] + (size_t)m * 1024, pp->in[6] + (size_t)(m + ngw) * 1024, m + ngw < 8192, pp->in[17], WSB(WS_MEMN) + (size_t)m * 1024, WSB(WS_MEMN) + (size_t)(m + ngw) * 1024, lane);
        for (size_t i0 = gt; i0 < (size_t)32 * 1024 * 32; i0 += 4 * ngt) { f32x4 a[4], bb[4];
#pragma unroll
            for (int k = 0; k < 4; ++k) { const size_t i = i0 + k * ngt, row = i >> 5; const int c8 = (int)(i & 31); if (i < (size_t)32 * 1024 * 32) { a[k] = *(const f32x4*)(pp->in[2] + row * 256 + c8 * 8); bb[k] = *(const f32x4*)(pp->in[2] + row * 256 + c8 * 8 + 4); } }
#pragma unroll
            for (int k = 0; k < 4; ++k) { const size_t i = i0 + k * ngt, row = i >> 5; const int c8 = (int)(i & 31); const size_t b = row >> 10, t = row & 1023; if (i < (size_t)32 * 1024 * 32) st8(WSB(WS_CKVALL) + (b * KPAD + t) * 256 + c8 * 8, a[k], bb[k]); } }
        for (size_t i = gt; i < (size_t)32 * 48 * 32; i += ngt) { const size_t rr = i >> 5; const int c8 = (int)(i & 31); const size_t b = rr / 48, t = KALL + rr % 48;
            *(u32x4*)(WSB(WS_CKVALL) + (b * KPAD + t) * 256 + c8 * 8) = (u32x4){0u, 0u, 0u, 0u}; }
        for (size_t i = gt; i < (size_t)32 * 1024 * 8; i += ngt) { const size_t row = i >> 3; const int c8 = (int)(i & 7); const size_t b = row >> 10, t = row & 1023;
            const float* s = pp->in[3] + row * 64; const f32x4 x1 = *(const f32x4*)(s + 4 * c8), x2 = *(const f32x4*)(s + 32 + 4 * c8);
            u32x4 w; w.x = pk2(x1[0], x2[0]); w.y = pk2(x1[1], x2[1]); w.z = pk2(x1[2], x2[2]); w.w = pk2(x1[3], x2[3]);
            *(u32x4*)(WSB(WS_KRALL) + (b * KPAD + t) * 64 + c8 * 8) = w; }
        for (size_t i = gt; i < (size_t)32 * 48 * 8; i += ngt) { const size_t rr = i >> 3; const int c8 = (int)(i & 7); const size_t b = rr / 48, t = KALL + rr % 48;
            *(u32x4*)(WSB(WS_KRALL) + (b * KPAD + t) * 64 + c8 * 8) = (u32x4){0u, 0u, 0u, 0u}; }
        for (size_t i0 = gt; i0 < (size_t)8192 * 128; i0 += 4 * ngt) { f32x4 a[4], bb[4];
#pragma unroll
            for (int k = 0; k < 4; ++k) { const size_t i = i0 + k * ngt; if (i < (size_t)8192 * 128) { a[k] = *(const f32x4*)(pp->in[4] + i * 8); bb[k] = *(const f32x4*)(pp->in[4] + i * 8 + 4); } }
#pragma unroll
            for (int k = 0; k < 4; ++k) { const size_t i = i0 + k * ngt; if (i < (size_t)8192 * 128) st8(WSB(WS_MKS) + i * 8, a[k], bb[k]); } }
    }
    GRID_BAR();
    if (gridDim.x == 0x7fffffffu) cg::this_grid().sync();
    PHASE_BEGIN;

    for (int g = 0; g < NGRP; ++g) {
        const size_t r0 = (size_t)g * MG;
        {
            EpiInproj E{WSB(WS_Z), WSB(WS_KR), out + O_KRP + r0 * 64, st_v + r0, st_q + r0, st_kv + r0, SEQ, SEQ, 0, 0};
            run_gemm(lds, WSB(WS_XN), 1024, WSB(WS_WIN), 1024, MG, NZ, 1024, false, E);
        }
        if (g == 0) {
            EpiInproj E{WSB(WS_ZS), WSB(WS_KRALL), out + O_KRS, st_v + MP, st_q + MP, st_kv + MP, TS, KPAD, PAST, PAST};
            run_gemm(lds, WSB(WS_XNS), 1024, WSB(WS_WIN), 1024, MS, NZ, 1024, true, E);
            EpiMemKV E2{out + O_MKP, out + O_MVP, WSB(WS_MK)};
            run_gemm(lds, WSB(WS_MEMN), 1024, WSB(WS_WKV), 1024, 8192, 2048, 1024, false, E2);
            EpiVT E3{WSB(WS_MVT), 256, nullptr};
            run_gemm(lds, WSB(WS_WKV) + (size_t)1024 * 1024, 1024, WSB(WS_MEMN), 1024, 1024, 8192, 1024, true, E3);
        }
        if (g == 1) { EpiMerge E2{WSB(WS_ZS) + ZGA + 1024, WSB(WS_MRGS), 0}; run_gemm(lds, WSB(WS_OMS), 1024, WSB(WS_WBM), 1024, MS, 1024, 1024, true, E2); }
        if (g == 2) { EpiOut E{pp->in[1], WSB(WS_HBS), st_h + MP}; run_gemm(lds, WSB(WS_MRGS), 1024, WSB(WS_WOUT), 1024, MS, 1024, 1024, true, E); }
        if (g == 3) { EpiDown E{out + O_YS, nullptr, WSB(WS_HBS)}; run_gemm(lds, WSB(WS_ACTS), DFF, WSB(WS_WDN), DFF, MS, 1024, 1408, true, E); }
        GRID_BAR();
        PHASE_BEGIN;
        {
            EpiQ E{WSB(WS_Q), st_q + r0, SEQ, 0};
            run_gemm(lds, WSB(WS_Z) + ZCQ, NZ, WSB(WS_WUQ), 384, MG, 1536, 384, false, E);
            EpiRowScale E2{WSB(WS_KN), 1024, st_kv + r0, 1.0f / 256.0f};
            run_gemm(lds, WSB(WS_Z) + ZCKV, NZ, WSB(WS_WUKF), 256, MG, 1024, 256, false, E2);
            EpiVT E3{WSB(WS_VT), SEQ, st_kv + r0};
            run_gemm(lds, WSB(WS_WUVF), 256, WSB(WS_Z) + ZCKV, NZ, 1024, MG, 256, false, E3);
            PHASE_BEGIN;
            for (size_t i0 = gt; i0 < (size_t)MG * 32; i0 += 4 * ngt) { u32x4 wv[4]; float sv4[4];
#pragma unroll
              for (int k = 0; k < 4; ++k) { size_t i = i0 + k * ngt; if (i >= (size_t)MG * 32) i = (size_t)MG * 32 - 1; const size_t row = i >> 5; const int c8 = (int)(i & 31); wv[k] = *(const u32x4*)(WSB(WS_Z) + row * NZ + ZCKV + c8 * 8); sv4[k] = st_kv[r0 + row]; }
#pragma unroll
              for (int k = 0; k < 4; ++k) { const size_t i = i0 + k * ngt, row = i >> 5; const int c8 = (int)(i & 31); if (i < (size_t)MG * 32) {
                const u32x4 w = wv[k]; const float rs = rsqrtf(sv4[k] * (1.0f / 256.0f) + EPS);
                const f32x4 g0 = *(const f32x4*)(pp->in[14] + c8 * 8), g1 = *(const f32x4*)(pp->in[14] + c8 * 8 + 4);
                float* o = out + O_CKVP + (r0 + row) * 256 + c8 * 8;
                *(f32x4*)o = (f32x4){bflo(w.x) * rs * g0[0], bfhi(w.x) * rs * g0[1], bflo(w.y) * rs * g0[2], bfhi(w.y) * rs * g0[3]};
                *(f32x4*)(o + 4) = (f32x4){bflo(w.z) * rs * g1[0], bfhi(w.z) * rs * g1[1], bflo(w.w) * rs * g1[2], bfhi(w.w) * rs * g1[3]}; } } }
        }
        if (g == 0) {
            EpiQ E{WSB(WS_QS), st_q + MP, TS, PAST};
            run_gemm(lds, WSB(WS_ZS) + ZCQ, NZ, WSB(WS_WUQ), 384, MS, 1536, 384, true, E);
            PHASE_BEGIN;
            for (size_t i = gt; i < (size_t)MS * 32; i += ngt) { const size_t row = i >> 5; const int c8 = (int)(i & 31);
                const u32x4 w = *(const u32x4*)(WSB(WS_ZS) + row * NZ + ZCKV + c8 * 8); const float rs = rsqrtf(st_kv[MP + row] * (1.0f / 256.0f) + EPS);
                const f32x4 g0 = *(const f32x4*)(pp->in[14] + c8 * 8), g1 = *(const f32x4*)(pp->in[14] + c8 * 8 + 4);
                const f32x4 a = {bflo(w.x) * rs * g0[0], bfhi(w.x) * rs * g0[1], bflo(w.y) * rs * g0[2], bfhi(w.y) * rs * g0[3]};
                const f32x4 b = {bflo(w.z) * rs * g1[0], bfhi(w.z) * rs * g1[1], bflo(w.w) * rs * g1[2], bfhi(w.w) * rs * g1[3]};
                float* o = out + O_CKVS + row * 256 + c8 * 8; *(f32x4*)o = a; *(f32x4*)(o + 4) = b;
                st8(WSB(WS_CKVALL) + ((row >> 4) * KPAD + PAST + (row & 15)) * 256 + c8 * 8, a, b); }
            for (size_t i = gt; i < (size_t)MS * 128; i += ngt) { const size_t row = i >> 7; const int c8 = (int)(i & 127);
                const u32x4 w = *(const u32x4*)(WSB(WS_ZS) + row * NZ + ZV + c8 * 8); const float rs = rsqrtf(st_v[MP + row] * (1.0f / 1024.0f) + EPS);
                const f32x4 g0 = *(const f32x4*)(pp->in[9] + c8 * 8), g1 = *(const f32x4*)(pp->in[9] + c8 * 8 + 4);
                float* o = out + O_GVS + row * 1024 + c8 * 8;
                *(f32x4*)o = (f32x4){bflo(w.x) * rs * g0[0], bfhi(w.x) * rs * g0[1], bflo(w.y) * rs * g0[2], bfhi(w.y) * rs * g0[3]};
                *(f32x4*)(o + 4) = (f32x4){bflo(w.z) * rs * g1[0], bfhi(w.z) * rs * g1[1], bflo(w.w) * rs * g1[2], bfhi(w.w) * rs * g1[3]}; }
        }
        GRID_BAR();
        PHASE_BEGIN;
        {
            for (int u0 = bid; u0 < 256; u0 += G) {
                const int uidx = (((u0 & 7) * 8 + (u0 >> 5)) << 2) + ((u0 >> 3) & 3);
                const int bh = uidx >> 2, b = bh >> 3, hh = bh & 7;
#pragma unroll 1
                for (int half = 0; half < 2; ++half) {
                    const int qb = half ? 7 - (uidx & 3) : (uidx & 3);
                    const size_t rowq = (size_t)b * SEQ + qb * 256;
                    attn_unit<192, true>(lds, WSB(WS_Q) + rowq * 1536 + hh * 192, 1536, 256, WSB(WS_KN) + (size_t)b * SEQ * 1024 + hh * 128, 1024, WSB(WS_KR) + (size_t)b * SEQ * 64,
                                         WSB(WS_VT) + ((size_t)b * 1024 + hh * 128) * SEQ, SEQ, 4 * qb + 4, 4 * qb + (wid >> 1) + 1, 1 << 30,
                                         WSB(WS_OM) + rowq * 1024 + hh * 128, 1024, tid, wid, lane);
                }
            }
            for (int u0 = bid; u0 < 512; u0 += G) {
                const int uidx = (u0 & 7) * 64 + ((u0 >> 3) & 31) + 32 * (u0 >> 8);
                const int vh = uidx & 1, qb = (uidx >> 1) & 7, hh = (uidx >> 4) & 3, b = uidx >> 6;
                const size_t rowq = (size_t)b * SEQ + qb * 256; const int bgl = g * BG + b;
                attn_unit<256, false>(lds, WSB(WS_Z) + rowq * NZ + ZQM + hh * 256, NZ, 256, WSB(WS_MK) + (size_t)bgl * 256 * 1024 + hh * 256, 1024, nullptr,
                                      WSB(WS_MVT) + ((size_t)bgl * 1024 + hh * 256 + vh * 128) * 256, 256, 4, 4, 1 << 30,
                                      WSB(WS_OE) + rowq * 1024 + hh * 256 + vh * 128, 1024, tid, wid, lane);
            }
            for (int uidx = bid; uidx < 1024; uidx += G) {
                const int gch = uidx & 7, ch = (uidx >> 3) & 15, b = uidx >> 7; const size_t row = (size_t)b * SEQ + ch * 128;
                gm_unit(lds, WSB(WS_Z) + row * NZ, 128, gch, WSB(WS_WS), pp->in[11], pp->in[9], st_v + r0 + row, WSB(WS_OG) + row * 1024, tid, wid, lane);
            }
        }
        if (g == 0) {
            EpiRowScale E2{WSB(WS_KNS), 1024, nullptr, 0.f};
            run_gemm(lds, WSB(WS_CKVALL), 256, WSB(WS_WUKP), 256, 32 * KPAD, 1024, 256, true, E2);
            EpiVT E3{WSB(WS_VTS), KPAD, nullptr};
            run_gemm(lds, WSB(WS_WUVP), 256, WSB(WS_CKVALL), 256, 1024, 32 * KPAD, 256, true, E3);
        }
        GRID_BAR();
        PHASE_BEGIN;
        {
            EpiMerge E1{WSB(WS_Z) + ZGA, WSB(WS_MRG), 1};
            run_gemm(lds, WSB(WS_OG), 1024, WSB(WS_WBG), 1024, MG, 1024, 1024, false, E1);
            EpiMerge E2{WSB(WS_Z) + ZGA + 1024, WSB(WS_MRG), 0};
            run_gemm(lds, WSB(WS_OM), 1024, WSB(WS_WBM), 1024, MG, 1024, 1024, false, E2);
            EpiMerge E3{WSB(WS_Z) + ZGA + 2048, WSB(WS_MRG), 0};
            run_gemm(lds, WSB(WS_OE), 1024, WSB(WS_WBE), 1024, MG, 1024, 1024, false, E3);
        }
        if (g == 0) {
            PHASE_BEGIN;
            for (int uidx = G - 1 - bid; uidx < 256; uidx += G) {
                const int b = uidx >> 3, hh = uidx & 7;
                attn_unit<192, true>(lds, WSB(WS_QS) + (size_t)b * TS * 1536 + hh * 192, 1536, TS, WSB(WS_KNS) + (size_t)b * KPAD * 1024 + hh * 128, 1024, WSB(WS_KRALL) + (size_t)b * KPAD * 64,
                                     WSB(WS_VTS) + ((size_t)b * 1024 + hh * 128) * KPAD, KPAD, 17, wid == 0 ? 17 : 0, KALL,
                                     WSB(WS_OMS) + (size_t)b * TS * 1024 + hh * 128, 1024, tid, wid, lane);
            }
            for (int uidx = G - 1 - bid; uidx < 256; uidx += G) {
                const int vh = uidx & 1, hh = (uidx >> 1) & 3, b = uidx >> 3;
                attn_unit<256, false, false>(lds, WSB(WS_ZS) + (size_t)b * TS * NZ + ZQM + hh * 256, NZ, TS, WSB(WS_MKS) + (size_t)b * 256 * 1024 + hh * 256, 1024, nullptr,
                                      WSB(WS_MVTS) + ((size_t)b * 1024 + hh * 256 + vh * 128) * 256, 256, 4, wid == 0 ? 4 : 0, 1 << 30,
                                      WSB(WS_OES) + (size_t)b * TS * 1024 + hh * 256 + vh * 128, 1024, tid, wid, lane);
            }
            for (int uidx = G - 1 - bid; uidx < 256; uidx += G) {
                const int gch = uidx & 7, b = uidx >> 3; const size_t row = (size_t)b * TS;
                gm_unit(lds, WSB(WS_ZS) + row * NZ, TS, gch, WSB(WS_WS), pp->in[11], pp->in[9], st_v + MP + row, WSB(WS_OGS) + row * 1024, tid, wid, lane);
            }
        }
        GRID_BAR();
        PHASE_BEGIN;
        {
            EpiOut E{pp->in[0] + r0 * 1024, WSB(WS_HB), st_h + r0};
            run_gemm(lds, WSB(WS_MRG), 1024, WSB(WS_WOUT), 1024, MG, 1024, 1024, false, E);
        }
        GRID_BAR();
        PHASE_BEGIN;
        {
            EpiFfnUp E{WSB(WS_ACT), st_h + r0};
            run_gemm(lds, WSB(WS_HB), 1024, WSB(WS_WGU), 1024, MG, NGU, 1024, false, E);
        }
        PHASE_BEGIN;
        if (g + 1 < NGRP && bid >= G / 2) { const size_t n0 = (size_t)(g + 1) * MG;
            const int st_ = (G - G / 2) * 8;
            for (int m = (bid - G / 2) * 8 + wid; m < MG; m += 2 * st_) rms_row2_bf16(pp->in[0] + (n0 + m) * 1024, pp->in[0] + (n0 + m + st_) * 1024, m + st_ < MG, pp->in[7], WSB(WS_XN) + (size_t)m * 1024, WSB(WS_XN) + (size_t)(m + st_) * 1024, lane); }
        if (g == 0) { EpiMerge E1{WSB(WS_ZS) + ZGA, WSB(WS_MRGS), 1}; run_gemm(lds, WSB(WS_OGS), 1024, WSB(WS_WBG), 1024, MS, 1024, 1024, true, E1); }
        if (g == 1) { EpiMerge E3{WSB(WS_ZS) + ZGA + 2048, WSB(WS_MRGS), 0}; run_gemm(lds, WSB(WS_OES), 1024, WSB(WS_WBE), 1024, MS, 1024, 1024, true, E3); }
        if (g == 2) { EpiFfnUp E{WSB(WS_ACTS), st_h + MP}; run_gemm(lds, WSB(WS_HBS), 1024, WSB(WS_WGU), 1024, MS, NGU, 1024, true, E); }
        if (g == 3) { EpiDown E{out + O_YS, st_h2 + MP, nullptr}; run_gemm(lds, WSB(WS_ACTS) + 1408, DFF, WSB(WS_WDN) + 1408, DFF, MS, 1024, 1408, true, E); }
        GRID_BAR();
        PHASE_BEGIN;
        {
            EpiDownNorm E{out + O_YP + r0 * 1024, st_h2 + r0, WSB(WS_HB), pp->in[27], (unsigned*)(ws + WS_BAR) + 4096 + 4096 * g};
            run_gemm(lds, WSB(WS_ACT), DFF, WSB(WS_WDN), DFF, MG, 1024, DFF, false, E);
        }
        PHASE_BEGIN;
    }
    {
        const size_t p0 = (size_t)(NGRP - 1) * MG;
        (void)p0;
        for (int m = gw; m < MS; m += ngw) {
            float* hr = out + O_YS + (size_t)m * 1024; const float ssq = st_h2[MP + m];
            const float rs = rsqrtf(ssq * (1.0f / 1024.0f) + EPS);
#pragma unroll
            for (int j = 0; j < 4; ++j) { const f32x4 gg = ((const f32x4*)pp->in[27])[lane + 64 * j]; f32x4 v = ((f32x4*)hr)[lane + 64 * j]; ((f32x4*)hr)[lane + 64 * j] = v * rs * gg; }
        }
    }
}

extern "C" void kernel_launch(void* const* d_in, const int* in_sizes, int n_in, void* d_out, int out_size, void* d_ws, size_t ws_size, hipStream_t stream) {
    static int grid = 0;
    if (grid == 0) {
        if (n_in != 28 || ws_size < WS_END) { fprintf(stderr, "kernel_launch: need 28 inputs and %zu bytes of workspace (got %d, %zu)\n", (size_t)WS_END, n_in, ws_size); grid = -1; return; }
        int dev = 0, cus = 0, per_cu = 0;
        hipGetDevice(&dev); hipDeviceGetAttribute(&cus, hipDeviceAttributeMultiprocessorCount, dev);
        if (hipFuncSetAttribute((const void*)fwd_mega, hipFuncAttributeMaxDynamicSharedMemorySize, LDS_BYTES) != hipSuccess) fprintf(stderr, "kernel_launch: hipFuncSetAttribute failed\n");
        if (hipOccupancyMaxActiveBlocksPerMultiprocessor(&per_cu, (const void*)fwd_mega, 512, LDS_BYTES) != hipSuccess || per_cu < 1) { fprintf(stderr, "kernel_launch: occupancy query says %d\n", per_cu); per_cu = 1; }
        (void)hipGetLastError();
        grid = cus > 0 ? cus : 256;
        if (grid != 256) fprintf(stderr, "kernel_launch: built for 256 CUs (got %d): the fused final norm needs one unit per workgroup\n", grid);
    }
    if (grid < 0) return;
    Params p{};
    for (int i = 0; i < 28; ++i) p.in[i] = (const float*)d_in[i];
    p.out = (float*)d_out; p.ws = (unsigned char*)d_ws;
    (void)hipMemsetAsync((char*)d_ws + WS_BAR, 0, 131072, stream);
    void* args[] = {&p};
    hipError_t e = hipLaunchCooperativeKernel((const void*)fwd_mega, dim3(grid), dim3(512), args, LDS_BYTES, stream);
    if (e != hipSuccess) fprintf(stderr, "cooperative launch failed: %s (grid %d)\n", hipGetErrorString(e), grid);
}
```
